# Optimizing an MI355X kernel written in HIP

```python
import math
import jax, jax.numpy as jnp
from jax import lax
import numpy as np

D_MODEL = 1024
BATCH = 16
SEQ = 2048
DEPTH = 2

N_A_LAYERS = DEPTH // 2
N_B_LAYERS = DEPTH - N_A_LAYERS
CONV_WIDTH = D_MODEL
CONV_KERNEL = 31
N_HEADS = D_MODEL // 128
HEAD_DIM = 64
V_DIM = 2 * HEAD_DIM
ATTN_WIDTH = N_HEADS * V_DIM
Q_BLOCK = 128
EPS = 1e-6

kernel_name = "yoco_conformer_diffattn_hybrid"


def _rms_norm(x, g):
    xf = x.astype(jnp.float32)
    y = xf * lax.rsqrt(jnp.mean(xf * xf, axis=-1, keepdims=True) + EPS)
    return (y * g.astype(jnp.float32)).astype(x.dtype)


def _layer_norm(x, g, b):
    xf = x.astype(jnp.float32)
    mu = jnp.mean(xf, axis=-1, keepdims=True)
    var = jnp.mean(jnp.square(xf - mu), axis=-1, keepdims=True)
    y = (xf - mu) * lax.rsqrt(var + EPS)
    return (y * g.astype(jnp.float32) + b.astype(jnp.float32)).astype(x.dtype)


def _alibi_slopes():
    i = jnp.arange(1, N_HEADS + 1, dtype=jnp.float32)
    return jnp.exp2(-8.0 * i / N_HEADS)


def _causal_depthwise_conv(u, w, b):
    k = w[:, None, :].astype(u.dtype)
    y = lax.conv_general_dilated(u, k, window_strides=(1,), padding=[(CONV_KERNEL - 1, 0)],
                                 dimension_numbers=("NWC", "WIO", "NWC"),
                                 feature_group_count=u.shape[-1])
    return y + b.astype(u.dtype)


def _conformer_conv_layer(x, g_pre, w_in, w_dw, b_dw, ln_g, ln_b, w_out, g_post):
    h = _rms_norm(x, g_pre)
    u = h @ w_in
    a, b, z = jnp.split(u, 3, axis=-1)
    c = a * jax.nn.sigmoid(b)
    c = _causal_depthwise_conv(c, w_dw, b_dw)
    c = jax.nn.silu(_layer_norm(c, ln_g, ln_b))
    y = (c * jax.nn.silu(z)) @ w_out
    return x + _rms_norm(y, g_post)


def _diff_attention(q, k, v, lam):
    bsz, seq = q.shape[0], q.shape[1]
    nblk = seq // Q_BLOCK
    qb = q.reshape(bsz, nblk, Q_BLOCK, N_HEADS, 2, HEAD_DIM).transpose(1, 0, 2, 3, 4, 5)
    slopes = _alibi_slopes()
    kpos = jnp.arange(seq)
    scale = HEAD_DIM ** -0.5

    def one_block(args):
        qi, blk = args
        qpos = blk * Q_BLOCK + jnp.arange(Q_BLOCK)
        dist = (qpos[:, None] - kpos[None, :]).astype(jnp.float32)
        bias = jnp.where(dist[None] >= 0, -slopes[:, None, None] * dist[None], -jnp.inf)
        s = jnp.einsum("bqhcd,bkhcd->bhcqk", qi, k, preferred_element_type=jnp.float32)
        p = jax.nn.softmax(s * scale + bias[None, :, None], axis=-1)
        attn = p[:, :, 0] - lam * p[:, :, 1]
        return jnp.einsum("bhqk,bkhe->bqhe", attn.astype(v.dtype), v)

    out = lax.map(one_block, (qb, jnp.arange(nblk)))
    return out.transpose(1, 0, 2, 3, 4).reshape(bsz, seq, N_HEADS, V_DIM)


def _diff_attn_layer(x, k, v, layer_idx, g_pre, w_in, lam_p, g_sub, w_out, g_post):
    bsz, seq = x.shape[0], x.shape[1]
    h = _rms_norm(x, g_pre)
    u = h @ w_in
    q = u[..., :2 * N_HEADS * HEAD_DIM].reshape(bsz, seq, N_HEADS, 2, HEAD_DIM)
    z = u[..., 2 * N_HEADS * HEAD_DIM:]
    lam_init = 0.8 - 0.6 * math.exp(-0.3 * layer_idx)
    lp = lam_p.astype(jnp.float32)
    lam = jnp.exp(jnp.sum(lp[0] * lp[1])) - jnp.exp(jnp.sum(lp[2] * lp[3])) + lam_init
    o = _diff_attention(q, k, v, lam)
    o = _rms_norm(o, g_sub) * (1.0 - lam_init)
    o = o.reshape(bsz, seq, ATTN_WIDTH).astype(x.dtype)
    y = (o * jax.nn.silu(z)) @ w_out
    return x + _rms_norm(y, g_post)


def setup_inputs(seed: int = 0) -> dict:
    key = jax.random.key(seed)
    ks = jax.random.split(key, 20)
    D, E, K = D_MODEL, CONV_WIDTH, CONV_KERNEL
    nA, nB = N_A_LAYERS, N_B_LAYERS
    nrm = lambda k, shape, fan: jax.random.normal(k, shape, jnp.float32) * fan ** -0.5
    gain = lambda k, shape: 1.0 + 0.02 * jax.random.normal(k, shape, jnp.float32)
    kv_cols = 2 * N_HEADS * HEAD_DIM + ATTN_WIDTH
    q_cols = 2 * N_HEADS * HEAD_DIM + ATTN_WIDTH
    return {
        "x": jax.random.normal(ks[0], (BATCH, SEQ, D), jnp.float32),
        "a_g_pre": gain(ks[1], (nA, D)),
        "a_w_in": nrm(ks[2], (nA, D, 3 * E), D),
        "a_w_dw": nrm(ks[3], (nA, K, E), K),
        "a_b_dw": 0.02 * jax.random.normal(ks[4], (nA, E), jnp.float32),
        "a_ln_g": gain(ks[5], (nA, E)),
        "a_ln_b": 0.02 * jax.random.normal(ks[6], (nA, E), jnp.float32),
        "a_w_out": nrm(ks[7], (nA, E, D), E),
        "a_g_post": gain(ks[8], (nA, D)),
        "kv_g": gain(ks[9], (D,)),
        "w_kv": nrm(ks[10], (D, kv_cols), D),
        "b_g_pre": gain(ks[11], (nB, D)),
        "b_w_in": nrm(ks[12], (nB, D, q_cols), D),
        "b_lambda": 0.1 * jax.random.normal(ks[13], (nB, 4, HEAD_DIM), jnp.float32),
        "b_g_sub": gain(ks[14], (nB, V_DIM)),
        "b_w_out": nrm(ks[15], (nB, ATTN_WIDTH, D), ATTN_WIDTH),
        "b_g_post": gain(ks[16], (nB, D)),
    }


def reference(x, a_g_pre, a_w_in, a_w_dw, a_b_dw, a_ln_g, a_ln_b, a_w_out, a_g_post,
              kv_g, w_kv, b_g_pre, b_w_in, b_lambda, b_g_sub, b_w_out, b_g_post):
    bsz, seq = x.shape[0], x.shape[1]
    k = v = None
    for l in range(DEPTH):
        if l < N_A_LAYERS:
            x = _conformer_conv_layer(x, a_g_pre[l], a_w_in[l], a_w_dw[l], a_b_dw[l],
                                      a_ln_g[l], a_ln_b[l], a_w_out[l], a_g_post[l])
        else:
            if l == N_A_LAYERS:
                kvh = _rms_norm(x, kv_g) @ w_kv
                k = kvh[..., :2 * N_HEADS * HEAD_DIM].reshape(bsz, seq, N_HEADS, 2, HEAD_DIM)
                v = kvh[..., 2 * N_HEADS * HEAD_DIM:].reshape(bsz, seq, N_HEADS, V_DIM)
            j = l - N_A_LAYERS
            x = _diff_attn_layer(x, k, v, l + 1, b_g_pre[j], b_w_in[j], b_lambda[j],
                                 b_g_sub[j], b_w_out[j], b_g_post[j])
    return x
```

```cpp
#include <hip/hip_runtime.h>
#include <hip/hip_cooperative_groups.h>
#include <cstdio>
#include <cstdint>
namespace cg = cooperative_groups;
namespace pg8 {
#define PG8_LAS __attribute__((address_space(3)))
typedef unsigned short bf16_t;
typedef short bf16x8 __attribute__((ext_vector_type(8)));
typedef float f32x4 __attribute__((ext_vector_type(4)));
typedef unsigned u32x4 __attribute__((ext_vector_type(4)));
constexpr int BM = 256, BK = 64, HALF = 128, HTB = HALF * BK * 2  , STAGE_BYTES = 8 * HTB, NXCD = 8, WGM = 8;

__host__ __device__ __forceinline__ int lds_byte(int r, int c) { const int st = (r >> 4) * 2 + (c >> 5), rr = r & 15, cc = c & 31, ob = rr * 64 + cc * 2; return st * 1024 + (ob ^ (((ob >> 9) & 1) << 5)); }
__host__ __device__ __forceinline__ void stage_rc(int b, int& R, int& C) { const int st = b / 1024, sb = b % 1024, swz = sb ^ (((sb >> 9) & 1) << 5); R = (st >> 1) * 16 + swz / 64; C = (st & 1) * 32 + (swz % 64) / 2; }
__host__ __device__ __forceinline__ int perm32(int rho) { const int n = rho >> 4, i = rho & 15; return 8 * (i >> 2) + 4 * n + (i & 3); }

struct Unit { int pm, pn; };
struct Gemm { const bf16_t* A; const bf16_t* Bt; int M, N, K; };

struct StaticOrder {
    int nM, nN, nwg, G, c, rep = 1;
    __host__ __device__ void init(int M, int N, int G_, int c_) { nM = M / BM; nN = N / BM; nwg = nM * nN; G = G_; c = c_; }
    __host__ __device__ bool next(int i, Unit& u) const {
        long L = (long)i * G + c; if (L >= (long)nwg * rep) return false;
        if (L >= nwg) L -= nwg;
        int wgid = (int)L; { const int q = nwg / NXCD, r = nwg % NXCD, xcd = wgid % NXCD, off = wgid / NXCD; wgid = (xcd < r ? xcd * (q + 1) : r * (q + 1) + (xcd - r) * q) + off; }
        const int nig = WGM * nN, gid = wgid / nig, fm = gid * WGM, gsz = (nM - fm) < WGM ? (nM - fm) : WGM;
        u.pm = fm + ((wgid % nig) % gsz); u.pn = (wgid % nig) / gsz; return true;
    }
    __device__ __forceinline__ void a_ready(const Unit&) const {}
    __device__ __forceinline__ void done(const Unit&) const {}
};

typedef float f32x2 __attribute__((ext_vector_type(2)));
typedef __bf16 bf16x2c __attribute__((ext_vector_type(2)));
__device__ __forceinline__ unsigned cvt_pk_bf16(float lo, float hi) { const f32x2 v = {lo, hi}; const bf16x2c b = __builtin_convertvector(v, bf16x2c); return __builtin_bit_cast(unsigned, b); }
template <class Epi, class Sched, bool ALIGN_EPI = false, bool SP2 = false>
__device__ __forceinline__ void gemm_phase(PG8_LAS unsigned char* lds, const Gemm g, const Sched& S, const Epi& E) {
    const int tid = threadIdx.x, wid = __builtin_amdgcn_readfirstlane(tid >> 6), lane = tid & 63, wr = wid >> 2, wc = wid & 3, fr = lane & 15, fq = lane >> 4;
    const int K = g.K, nt = K / BK;
    unsigned voffA[2], voffB[2];
#pragma unroll
    for (int i = 0; i < 2; ++i) { int R, C; stage_rc(tid * 16 + i * 8192, R, C); const int Rb = Epi::PERM ? ((R & ~31) + perm32(R & 31)) : R;
        voffA[i] = (unsigned)(R * K + C) * 2u; voffB[i] = (unsigned)(Rb * K + C) * 2u; }
    const size_t kstep = (size_t)(BK * 2);
    const size_t hstep = (size_t)HALF * K * 2;
    const size_t tstep = 2 * hstep;
    const unsigned ldsw = (unsigned)wid * 1024u;
    const int aoff = lds_byte(wr * 64 + fr, fq * 8), boff = lds_byte(wc * 32 + fr, fq * 8);
#define PG8_SA(b, h) (((b) * 2 + (h)) * HTB)
#define PG8_SB(b, h) ((4 + (b) * 2 + (h)) * HTB)
#define PG8_STAGE(bufoff, gbase, voff) do { _Pragma("unroll") for (int _i = 0; _i < 2; ++_i) \
        __builtin_amdgcn_global_load_lds((const unsigned*)((const char*)(gbase) + (voff)[_i]), (PG8_LAS unsigned*)(lds + (bufoff) + ldsw + _i * 8192), 16, 0, 0); } while (0)
#define PG8_LDA(dst, b, h) do { _Pragma("unroll") for (int m = 0; m < 4; ++m) _Pragma("unroll") for (int k = 0; k < 2; ++k) dst[m][k] = *(const PG8_LAS bf16x8*)(lds + PG8_SA(b, h) + aoff + m * 2048 + k * 1024); } while (0)
#define PG8_LDB(dst, b, h) do { _Pragma("unroll") for (int n = 0; n < 2; ++n) _Pragma("unroll") for (int k = 0; k < 2; ++k) dst[n][k] = *(const PG8_LAS bf16x8*)(lds + PG8_SB(b, h) + boff + n * 2048 + k * 1024); } while (0)
#define PG8_MMA(ai, bj, At, Bt) do { __builtin_amdgcn_s_setprio(1); _Pragma("unroll") for (int m = 0; m < 4; ++m) _Pragma("unroll") for (int n = 0; n < 2; ++n) _Pragma("unroll") for (int k = 0; k < 2; ++k) \
        acc[ai][bj][m][n] = __builtin_amdgcn_mfma_f32_16x16x32_bf16(Bt[n][k], At[m][k], acc[ai][bj][m][n], 0, 0, 0); __builtin_amdgcn_s_setprio(0); } while (0)
#define PG8_WAIT_V(n) asm volatile("s_waitcnt vmcnt(" #n ")" ::: "memory")
#define PG8_WAIT_L(n) asm volatile("s_waitcnt lgkmcnt(" #n ")" ::: "memory")
#define PG8_BAR __builtin_amdgcn_s_barrier()
#define PG8_SCHED __builtin_amdgcn_sched_barrier(0)
    Unit cur, nxt; int ui = 0;
    if (!S.next(0, cur)) return;
    f32x4 acc[2][2][4][2];
#pragma unroll
    for (int a = 0; a < 2; ++a)
#pragma unroll
        for (int b = 0; b < 2; ++b)
#pragma unroll
            for (int m = 0; m < 4; ++m)
#pragma unroll
                for (int n = 0; n < 2; ++n) acc[a][b][m][n] = (f32x4){0.f, 0.f, 0.f, 0.f};
    bf16x8 At[4][2], B0[2][2], B1[2][2];
    const char* cA = (const char*)g.A + (size_t)cur.pm * tstep; const char* cB = (const char*)g.Bt + (size_t)cur.pn * tstep;
    S.a_ready(cur);
    if constexpr (SP2) {
        PG8_STAGE(PG8_SB(0, 0), cB, voffB); PG8_STAGE(PG8_SB(0, 1), cB + hstep, voffB); PG8_STAGE(PG8_SA(0, 0), cA, voffA); PG8_STAGE(PG8_SA(0, 1), cA + hstep, voffA);
        if (wr == 1) PG8_BAR;
        PG8_WAIT_V(2); PG8_BAR;
        PG8_STAGE(PG8_SB(1, 0), cB + kstep, voffB); PG8_STAGE(PG8_SA(1, 0), cA + kstep, voffA); PG8_STAGE(PG8_SB(1, 1), cB + hstep + kstep, voffB);
        PG8_WAIT_V(6); PG8_BAR;
    } else {
        PG8_STAGE(PG8_SB(0, 0), cB, voffB); PG8_STAGE(PG8_SA(0, 0), cA, voffA); PG8_STAGE(PG8_SB(0, 1), cB + hstep, voffB); PG8_STAGE(PG8_SA(0, 1), cA + hstep, voffA);
        if (wr == 1) PG8_BAR;
        PG8_WAIT_V(4); PG8_BAR;
        PG8_STAGE(PG8_SB(1, 0), cB + kstep, voffB); PG8_STAGE(PG8_SA(1, 0), cA + kstep, voffA); PG8_STAGE(PG8_SB(1, 1), cB + hstep + kstep, voffB);
        PG8_WAIT_V(6); PG8_BAR;
    }
    for (;;) {
        const bool has_next = S.next(ui + 1, nxt);
        const char* nA = has_next ? (const char*)g.A + (size_t)nxt.pm * tstep : cA; const char* nB = has_next ? (const char*)g.Bt + (size_t)nxt.pn * tstep : cB;
        for (int t = 0; t < nt; t += 2) {
            const bool last = (t == nt - 2);
            const char* a1 = cA + (size_t)(t + 1) * kstep;
            const char* a2 = last ? nA : cA + (size_t)(t + 2) * kstep; const char* b2 = last ? nB : cB + (size_t)(t + 2) * kstep;
            const char* a3 = a2 + kstep; const char* b3 = b2 + kstep;
            if (last && has_next) S.a_ready(nxt);
            if constexpr (SP2) {
            PG8_LDB(B0, 0, 0); PG8_LDB(B1, 0, 1); PG8_SCHED; PG8_LDA(At, 0, 0); PG8_STAGE(PG8_SA(1, 1), a1 + hstep, voffA);
            PG8_WAIT_V(8); PG8_WAIT_L(0); PG8_BAR; PG8_MMA(0, 0, At, B0); PG8_MMA(0, 1, At, B1); PG8_BAR; PG8_SCHED;
            PG8_LDA(At, 0, 1); PG8_STAGE(PG8_SB(0, 0), b2, voffB); PG8_STAGE(PG8_SB(0, 1), b2 + hstep, voffB); PG8_STAGE(PG8_SA(0, 0), a2, voffA);
            PG8_WAIT_V(8); PG8_WAIT_L(0); PG8_BAR; PG8_MMA(1, 0, At, B0); PG8_MMA(1, 1, At, B1); PG8_BAR; PG8_SCHED;
            PG8_LDB(B0, 1, 0); PG8_LDB(B1, 1, 1); PG8_SCHED; PG8_LDA(At, 1, 0); PG8_STAGE(PG8_SA(0, 1), a2 + hstep, voffA);
            PG8_WAIT_V(8); PG8_WAIT_L(0); PG8_BAR; PG8_MMA(0, 0, At, B0); PG8_MMA(0, 1, At, B1); PG8_BAR; PG8_SCHED;
            PG8_LDA(At, 1, 1); PG8_STAGE(PG8_SB(1, 0), b3, voffB); PG8_STAGE(PG8_SB(1, 1), b3 + hstep, voffB); PG8_STAGE(PG8_SA(1, 0), a3, voffA);
            PG8_WAIT_V(8); PG8_WAIT_L(0); PG8_BAR; PG8_MMA(1, 0, At, B0); PG8_MMA(1, 1, At, B1); PG8_BAR; PG8_SCHED;
            } else {
            PG8_LDB(B0, 0, 0); PG8_SCHED; PG8_LDA(At, 0, 0); PG8_STAGE(PG8_SA(1, 1), a1 + hstep, voffA);
            PG8_WAIT_L(8); PG8_BAR; PG8_WAIT_L(0); PG8_MMA(0, 0, At, B0); PG8_BAR; PG8_SCHED;
            PG8_LDB(B1, 0, 1); PG8_STAGE(PG8_SB(0, 0), b2, voffB);
            PG8_BAR; PG8_WAIT_L(0); PG8_MMA(0, 1, At, B1); PG8_BAR;
            PG8_LDA(At, 0, 1); PG8_STAGE(PG8_SA(0, 0), a2, voffA);
            PG8_BAR; PG8_WAIT_L(0); PG8_MMA(1, 0, At, B0); PG8_BAR; PG8_SCHED;
            PG8_STAGE(PG8_SB(0, 1), b2 + hstep, voffB);
            PG8_WAIT_V(6); PG8_BAR; PG8_MMA(1, 1, At, B1); PG8_BAR;
            PG8_LDB(B0, 1, 0); PG8_SCHED; PG8_LDA(At, 1, 0); PG8_STAGE(PG8_SA(0, 1), a2 + hstep, voffA);
            PG8_WAIT_L(8); PG8_BAR; PG8_WAIT_L(0); PG8_MMA(0, 0, At, B0); PG8_BAR; PG8_SCHED;
            PG8_LDB(B1, 1, 1); PG8_STAGE(PG8_SB(1, 0), b3, voffB);
            PG8_BAR; PG8_WAIT_L(0); PG8_MMA(0, 1, At, B1); PG8_BAR;
            PG8_LDA(At, 1, 1); PG8_STAGE(PG8_SA(1, 0), a3, voffA);
            PG8_BAR; PG8_WAIT_L(0); PG8_MMA(1, 0, At, B0); PG8_BAR; PG8_SCHED;
            PG8_STAGE(PG8_SB(1, 1), b3 + hstep, voffB);
            PG8_WAIT_V(6); PG8_BAR; PG8_MMA(1, 1, At, B1); PG8_BAR;
            }
        }
        if constexpr (ALIGN_EPI) { if (wr == 0) PG8_BAR; }
        if constexpr (!Epi::AFTER_DRAIN) { E(acc, cur, wr, wc, fr, fq); S.done(cur); }
        if (!has_next) break;
#pragma unroll
        for (int a = 0; a < 2; ++a)
#pragma unroll
            for (int b = 0; b < 2; ++b)
#pragma unroll
                for (int m = 0; m < 4; ++m)
#pragma unroll
                    for (int n = 0; n < 2; ++n) acc[a][b][m][n] = (f32x4){0.f, 0.f, 0.f, 0.f};
        cur = nxt; cA = nA; cB = nB; ++ui;
        if constexpr (ALIGN_EPI) { if (wr == 1) PG8_BAR; }
    }
    PG8_WAIT_V(0);
    if constexpr (!ALIGN_EPI) { if (wr == 0) PG8_BAR; }
    PG8_BAR;
    if constexpr (Epi::AFTER_DRAIN) { E.fused(acc, cur, wr, wc, fr, fq, lds, wid, lane); S.done(cur); }
#undef PG8_SA
#undef PG8_SB
#undef PG8_STAGE
#undef PG8_LDA
#undef PG8_LDB
#undef PG8_MMA
#undef PG8_WAIT_V
#undef PG8_WAIT_L
#undef PG8_BAR
#undef PG8_SCHED
}
}

namespace pg8 {
__device__ __forceinline__ float sigm(float v) { return __builtin_amdgcn_rcpf(1.f + __builtin_amdgcn_exp2f(-1.4426950408889634f * v)); }
struct EpiPlain {
    static constexpr bool PERM = true, AFTER_DRAIN = false;
    bf16_t* O; int ldc; float scale;
    __device__ __forceinline__ void operator()(const f32x4 (&acc)[2][2][4][2], const Unit& u, int wr, int wc, int fr, int fq) const {
        const int row0 = u.pm * BM + wr * 64 + fr, col0 = u.pn * BM + wc * 32 + 8 * fq;
#pragma unroll
        for (int ai = 0; ai < 2; ++ai)
#pragma unroll
            for (int m = 0; m < 4; ++m) { bf16_t* rowp = O + (size_t)(row0 + ai * HALF + m * 16) * ldc + col0;
#pragma unroll
                for (int bj = 0; bj < 2; ++bj) { const f32x4 v0 = acc[ai][bj][m][0] * scale, v1 = acc[ai][bj][m][1] * scale;
                    u32x4 w; w.x = cvt_pk_bf16(v0[0], v0[1]); w.y = cvt_pk_bf16(v0[2], v0[3]); w.z = cvt_pk_bf16(v1[0], v1[1]); w.w = cvt_pk_bf16(v1[2], v1[3]);
                    *(u32x4*)(rowp + bj * HALF) = w; } }
    }
};
struct EpiGlu {
    static constexpr bool PERM = true, AFTER_DRAIN = false;
    bf16_t* G; bf16_t* SZ;
    __device__ __forceinline__ void operator()(const f32x4 (&acc)[2][2][4][2], const Unit& u, int wr, int wc, int fr, int fq) const {
        const int row0 = u.pm * BM + wr * 64 + fr;
        if (u.pn < 8) {
            const int col0 = u.pn * HALF + wc * 32 + 8 * fq;
#pragma unroll
            for (int ai = 0; ai < 2; ++ai)
#pragma unroll
                for (int m = 0; m < 4; ++m) { bf16_t* rowp = G + (size_t)(row0 + ai * HALF + m * 16) * 1024 + col0;
                    f32x4 v0, v1;
#pragma unroll
                    for (int j = 0; j < 4; ++j) { v0[j] = acc[ai][0][m][0][j] * sigm(acc[ai][1][m][0][j]); v1[j] = acc[ai][0][m][1][j] * sigm(acc[ai][1][m][1][j]); }
                    u32x4 w; w.x = cvt_pk_bf16(v0[0], v0[1]); w.y = cvt_pk_bf16(v0[2], v0[3]); w.z = cvt_pk_bf16(v1[0], v1[1]); w.w = cvt_pk_bf16(v1[2], v1[3]);
                    *(u32x4*)rowp = w; }
        } else {
            const int col0 = (u.pn - 8) * BM + wc * 32 + 8 * fq;
#pragma unroll
            for (int ai = 0; ai < 2; ++ai)
#pragma unroll
                for (int m = 0; m < 4; ++m) { bf16_t* rowp = SZ + (size_t)(row0 + ai * HALF + m * 16) * 1024 + col0;
#pragma unroll
                    for (int bj = 0; bj < 2; ++bj) { f32x4 v0 = acc[ai][bj][m][0], v1 = acc[ai][bj][m][1];
#pragma unroll
                        for (int j = 0; j < 4; ++j) { v0[j] = v0[j] * sigm(v0[j]); v1[j] = v1[j] * sigm(v1[j]); }
                        u32x4 w; w.x = cvt_pk_bf16(v0[0], v0[1]); w.y = cvt_pk_bf16(v0[2], v0[3]); w.z = cvt_pk_bf16(v1[0], v1[1]); w.w = cvt_pk_bf16(v1[2], v1[3]);
                        *(u32x4*)(rowp + bj * HALF) = w; } }
        }
    }
};
struct EpiKQZ {
    static constexpr bool PERM = true, AFTER_DRAIN = false;
    bf16_t* Kb; size_t seg_stride; float qscale;
    __device__ __forceinline__ void operator()(const f32x4 (&acc)[2][2][4][2], const Unit& u, int wr, int wc, int fr, int fq) const {
        const int row0 = u.pm * BM + wr * 64 + fr; const int seg = u.pn >> 2;
        bf16_t* base = Kb + (size_t)seg * seg_stride;
        const float sc = seg == 1 ? qscale : 1.f;
        const int col0 = (u.pn & 3) * BM + wc * 32 + 8 * fq;
#pragma unroll
        for (int ai = 0; ai < 2; ++ai)
#pragma unroll
            for (int m = 0; m < 4; ++m) { bf16_t* rowp = base + (size_t)(row0 + ai * HALF + m * 16) * 1024 + col0;
#pragma unroll
                for (int bj = 0; bj < 2; ++bj) { f32x4 v0 = acc[ai][bj][m][0] * sc, v1 = acc[ai][bj][m][1] * sc;
                    if (seg == 2) {
#pragma unroll
                        for (int j = 0; j < 4; ++j) { v0[j] = v0[j] * sigm(v0[j]); v1[j] = v1[j] * sigm(v1[j]); } }
                    u32x4 w; w.x = cvt_pk_bf16(v0[0], v0[1]); w.y = cvt_pk_bf16(v0[2], v0[3]); w.z = cvt_pk_bf16(v1[0], v1[1]); w.w = cvt_pk_bf16(v1[2], v1[3]);
                    *(u32x4*)(rowp + bj * HALF) = w; } }
    }
};
}

#define LAS __attribute__((address_space(3)))
typedef pg8::bf16_t bf16_t;
typedef pg8::bf16x8 bf16x8;
typedef pg8::f32x4 f32x4;
typedef pg8::u32x4 u32x4;
typedef float f32x16 __attribute__((ext_vector_type(16)));
typedef float f32x2v __attribute__((ext_vector_type(2)));
typedef unsigned u32x2 __attribute__((ext_vector_type(2)));

constexpr int BATCH = 16, SEQ = 2048, DM = 1024, MTOK = BATCH * SEQ;
constexpr int NH = 8, CK = 31;
constexpr float EPS = 1e-6f;
constexpr float LOG2E = 1.4426950408889634f;
constexpr float LAM_INIT = 0.4707130183435842f;
constexpr int NTHREADS = 512, NWAVES = 8;
constexpr int P0_NWT = 2, P4_NWT = 2;
constexpr int NRF0 = 8;
constexpr int NRF = 4;
constexpr int LDS_BYTES = 163840;
constexpr size_t MiB = 1u << 20;
constexpr size_t WS_WT1 = 0, WS_WT2 = 6 * MiB, WS_WT3 = 8 * MiB, WS_WT3V = 14 * MiB, WS_WT4 = 16 * MiB;
constexpr size_t WS_CTL = 20 * MiB, CTL_BYTES = 16384;
constexpr size_t WS_A = 32 * MiB, WS_B = 96 * MiB, WS_C = 160 * MiB, WS_F = 224 * MiB, WS_G = 288 * MiB, WS_H = 352 * MiB, WS_END = 416 * MiB;

struct Args { const float* in[17]; float* out; unsigned char* ws; int ph_lo, ph_hi; };

__device__ __forceinline__ float wave_sum(float v) {
#pragma unroll
    for (int o = 1; o < 64; o <<= 1) v += __shfl_xor(v, o);
    return v;
}
typedef __bf16 bf16x2_t __attribute__((ext_vector_type(2)));
__device__ __forceinline__ unsigned pk2(float lo, float hi) { const f32x2v v = {lo, hi}; const bf16x2_t b = __builtin_convertvector(v, bf16x2_t); return __builtin_bit_cast(unsigned, b); }
__device__ __forceinline__ float bflo(unsigned u) { return __builtin_bit_cast(float, u << 16); }
__device__ __forceinline__ float bfhi(unsigned u) { return __builtin_bit_cast(float, u & 0xffff0000u); }
#define LDS_WAIT() asm volatile("s_waitcnt lgkmcnt(0)" ::: "memory")

__device__ __forceinline__ void transpose_item(const float* W, int ldw, int col0, const float* gain, bf16_t* WT, int dst_row0, LAS float* scr, int kb, int lane) {
    const int k0 = 64 * kb;
    float wv[32];
#pragma unroll
    for (int i = 0; i < 32; ++i) { const int kk = 2 * i + (lane >> 5); wv[i] = W[(size_t)(k0 + kk) * ldw + col0 + (lane & 31)]; }
#pragma unroll
    for (int i = 0; i < 32; ++i) { const int kk = 2 * i + (lane >> 5); const float gg = gain ? gain[k0 + kk] : 1.f; scr[kk * 33 + (lane & 31)] = wv[i] * gg; }
    LDS_WAIT();
    const int c = lane & 7;
#pragma unroll
    for (int j = 0; j < 4; ++j) { const int n = (lane >> 3) + 8 * j; const LAS float* s = scr + (8 * c) * 33 + n;
        u32x4 o; o.x = pk2(s[0 * 33], s[1 * 33]); o.y = pk2(s[2 * 33], s[3 * 33]); o.z = pk2(s[4 * 33], s[5 * 33]); o.w = pk2(s[6 * 33], s[7 * 33]);
        *(u32x4*)(WT + (size_t)(dst_row0 + n) * 1024 + k0 + 8 * c) = o; }
    LDS_WAIT();
}

__device__ __forceinline__ void rms_row_to_bf16(const float* xrow, bf16_t* orow, int lane) {
    const f32x4* xr = (const f32x4*)xrow + lane;
    f32x4 v[4]; float s = 0.f;
#pragma unroll
    for (int j = 0; j < 4; ++j) { v[j] = xr[64 * j]; s += (v[j].x * v[j].x + v[j].y * v[j].y) + (v[j].z * v[j].z + v[j].w * v[j].w); }
    const float r = rsqrtf(wave_sum(s) * (1.f / DM) + EPS);
    u32x2* o8 = (u32x2*)orow + lane;
#pragma unroll
    for (int j = 0; j < 4; ++j) { u32x2 w; w.x = pk2(v[j].x * r, v[j].y * r); w.y = pk2(v[j].z * r, v[j].w * r); o8[64 * j] = w; }
}

__device__ __forceinline__ void p0_phase(const Args& a, LAS unsigned char* lds, int lane, int wave) {
    LAS float* scr = (LAS float*)(lds + wave * 16384);
    constexpr int NWT = P0_NWT, NWR = NWAVES - NWT;
    unsigned char* ws = a.ws;
    const bool is_tw = wave >= NWR;
    const int gw = is_tw ? blockIdx.x * NWT + (wave - NWR) : blockIdx.x * NWR + wave, NGW = is_tw ? gridDim.x * NWT : gridDim.x * NWR;
    if (is_tw)
    for (int it = gw; it < 4 * 512; it += NGW) {
        const int piece = it >> 9, r = it & 511, kb = r >> 5, cb = (r & 31) * 32;
        switch (piece) {
        case 0: transpose_item(a.in[2], 3072, cb, a.in[1], (bf16_t*)(ws + WS_WT1), (cb >> 7) * 256 + (cb & 127), scr, kb, lane); break;
        case 1: transpose_item(a.in[2], 3072, 1024 + cb, a.in[1], (bf16_t*)(ws + WS_WT1), (cb >> 7) * 256 + 128 + (cb & 127), scr, kb, lane); break;
        case 2: transpose_item(a.in[2], 3072, 2048 + cb, a.in[1], (bf16_t*)(ws + WS_WT1), 2048 + cb, scr, kb, lane); break;
        case 3: transpose_item(a.in[7], 1024, cb, nullptr, (bf16_t*)(ws + WS_WT2), cb, scr, kb, lane); break;
        case 4: transpose_item(a.in[10], 2048, cb, a.in[9], (bf16_t*)(ws + WS_WT3), cb, scr, kb, lane); break;
        case 5: transpose_item(a.in[10], 2048, 1024 + cb, a.in[9], (bf16_t*)(ws + WS_WT3V), cb, scr, kb, lane); break;
        case 6: transpose_item(a.in[12], 2048, cb, a.in[11], (bf16_t*)(ws + WS_WT3), 1024 + cb, scr, kb, lane); break;
        case 7: transpose_item(a.in[12], 2048, 1024 + cb, a.in[11], (bf16_t*)(ws + WS_WT3), 2048 + cb, scr, kb, lane); break;
        default: transpose_item(a.in[15], 1024, cb, nullptr, (bf16_t*)(ws + WS_WT4), cb, scr, kb, lane); break;
        }
    }
    bf16_t* xn0 = (bf16_t*)(ws + WS_A);
    if (!is_tw)
    for (int m0 = gw; m0 < MTOK; m0 += NRF0 * NGW) {
        f32x4 v[NRF0][4];
#pragma unroll
        for (int rr = 0; rr < NRF0; ++rr) { const int m = m0 + rr * NGW; if (m < MTOK) { const f32x4* xr = (const f32x4*)(a.in[0] + (size_t)m * DM) + lane;
#pragma unroll
            for (int j = 0; j < 4; ++j) v[rr][j] = __builtin_nontemporal_load(xr + 64 * j); } }
#pragma unroll
        for (int rr = 0; rr < NRF0; ++rr) { const int m = m0 + rr * NGW; if (m < MTOK) { float sq = 0.f;
#pragma unroll
            for (int j = 0; j < 4; ++j) sq += (v[rr][j].x * v[rr][j].x + v[rr][j].y * v[rr][j].y) + (v[rr][j].z * v[rr][j].z + v[rr][j].w * v[rr][j].w);
            const float r = rsqrtf(wave_sum(sq) * (1.f / DM) + EPS);
            u32x2* o8 = (u32x2*)(xn0 + (size_t)m * DM) + lane;
#pragma unroll
            for (int j = 0; j < 4; ++j) { u32x2 w; w.x = pk2(v[rr][j].x * r, v[rr][j].y * r); w.y = pk2(v[rr][j].z * r, v[rr][j].w * r); o8[64 * j] = w; } } }
    }
}

__device__ __forceinline__ void late_weights(const Args& a, LAS unsigned char* lds, int lane, int tw, int ntw_block) {
    LAS float* scr = (LAS float*)(lds + tw * 16384);
    unsigned char* ws = a.ws;
    const int gw = blockIdx.x * ntw_block + tw, NGW = gridDim.x * ntw_block;
    for (int it = 4 * 512 + gw; it < 9 * 512; it += NGW) {
        const int piece = it >> 9, r = it & 511, kb = r >> 5, cb = (r & 31) * 32;
        switch (piece) {
        case 4: transpose_item(a.in[10], 2048, cb, a.in[9], (bf16_t*)(ws + WS_WT3), cb, scr, kb, lane); break;
        case 5: transpose_item(a.in[10], 2048, 1024 + cb, a.in[9], (bf16_t*)(ws + WS_WT3V), cb, scr, kb, lane); break;
        case 6: transpose_item(a.in[12], 2048, cb, a.in[11], (bf16_t*)(ws + WS_WT3), 1024 + cb, scr, kb, lane); break;
        case 7: transpose_item(a.in[12], 2048, 1024 + cb, a.in[11], (bf16_t*)(ws + WS_WT3), 2048 + cb, scr, kb, lane); break;
        default: transpose_item(a.in[15], 1024, cb, nullptr, (bf16_t*)(ws + WS_WT4), cb, scr, kb, lane); break;
        }
    }
}

#define RS_STEP(N, MASK) { const bool up_ = (lane & (MASK)) != 0; _Pragma("unroll") for (int i_ = 0; i_ < (N) / 2; ++i_) { \
        const float keep_ = up_ ? rv[i_ + (N) / 2] : rv[i_], send_ = up_ ? rv[i_] : rv[i_ + (N) / 2]; rv[i_] = keep_ + __shfl_xor(send_, (MASK)); } }
__device__ __forceinline__ void conv_phase(LAS unsigned char* lds, const bf16_t* g, const bf16_t* sz, bf16_t* cgo,
                                           const float* wdw, const float* bdw, const float* lng, const float* lnb) {
    const int tid = threadIdx.x, lane = tid & 63, wave = tid >> 6;
    LAS float* red = (LAS float*)(lds + 131072);
    LAS float* stat = red + 128;
    f32x2v w[CK];
#pragma unroll
    for (int k = 0; k < CK; ++k) w[k] = *(const f32x2v*)(wdw + k * 1024 + 2 * tid);
    const f32x2v bb = *(const f32x2v*)(bdw + 2 * tid), lg = *(const f32x2v*)(lng + 2 * tid), lb = *(const f32x2v*)(lnb + 2 * tid);
    for (int chunk = blockIdx.x; chunk < MTOK / 128; chunk += gridDim.x) {
        const int c0 = chunk * 128, s0 = c0 & (SEQ - 1);
        __syncthreads();
        for (int id = tid; id < 62 * 128; id += NTHREADS) { const int row = id >> 7, ch = id & 127;
            u32x4 v = {0u, 0u, 0u, 0u};
            if (s0 - 30 + row >= 0) v = *(const u32x4*)(g + (size_t)(c0 - 30 + row) * 1024 + ch * 8);
            *(LAS u32x4*)(lds + row * 2048 + ch * 16) = v; }
        __syncthreads();
#pragma unroll 1
        for (int tile = 0; tile < 4; ++tile) {
            u32x4 pf[8];
            if (tile < 3) {
#pragma unroll
                for (int i = 0; i < 8; ++i) { const int id = tid + NTHREADS * i; pf[i] = __builtin_nontemporal_load((const u32x4*)(g + (size_t)(c0 + 32 + 32 * tile + (id >> 7)) * 1024 + (id & 127) * 8)); } }
#pragma unroll 1
            for (int gq = 0; gq < 4; ++gq) {
                const int rbase = (32 * tile + 8 * gq) & 63;
                f32x2v v[38];
#pragma unroll
                for (int i = 0; i < 38; ++i) { const int slot = (rbase + i) & 63; const unsigned u = *(const LAS unsigned*)(lds + slot * 2048 + tid * 4); v[i] = (f32x2v){bflo(u), bfhi(u)}; }
                unsigned zz[8];
#pragma unroll
                for (int tt = 0; tt < 8; ++tt) zz[tt] = *(const unsigned*)(sz + (size_t)(c0 + 32 * tile + gq * 8 + tt) * 1024 + 2 * tid);
                f32x2v cv[8];
#pragma unroll
                for (int tt = 0; tt < 8; ++tt) { f32x2v acc = bb;
#pragma unroll
                    for (int k = 0; k < CK; ++k) acc = __builtin_elementwise_fma(w[k], v[tt + k], acc);
                    cv[tt] = acc; }
                float rv[16];
#pragma unroll
                for (int tt = 0; tt < 8; ++tt) { rv[2 * tt] = cv[tt].x + cv[tt].y; rv[2 * tt + 1] = cv[tt].x * cv[tt].x + cv[tt].y * cv[tt].y; }
                RS_STEP(16, 32) RS_STEP(8, 16) RS_STEP(4, 8) RS_STEP(2, 4)
                rv[0] += __shfl_xor(rv[0], 2); rv[0] += __shfl_xor(rv[0], 1);
                if ((lane & 3) == 0) red[wave * 16 + (lane >> 2)] = rv[0];
                __syncthreads();
                if (tid < 8) { float s = 0.f, q = 0.f;
#pragma unroll
                    for (int ww = 0; ww < 8; ++ww) { s += red[ww * 16 + 2 * tid]; q += red[ww * 16 + 2 * tid + 1]; }
                    const float mu = s * (1.f / 1024.f), var = fmaxf(q * (1.f / 1024.f) - mu * mu, 0.f);
                    stat[2 * tid] = mu; stat[2 * tid + 1] = rsqrtf(var + EPS); }
                __syncthreads();
#pragma unroll
                for (int tt = 0; tt < 8; ++tt) { const float mu = stat[2 * tt], rs = stat[2 * tt + 1];
                    float n0 = (cv[tt].x - mu) * rs * lg.x + lb.x, n1 = (cv[tt].y - mu) * rs * lg.y + lb.y;
                    n0 = n0 * pg8::sigm(n0) * bflo(zz[tt]); n1 = n1 * pg8::sigm(n1) * bfhi(zz[tt]);
                    *(unsigned*)(cgo + (size_t)(c0 + 32 * tile + gq * 8 + tt) * 1024 + 2 * tid) = pk2(n0, n1); }
            }
            if (tile < 3) {
#pragma unroll
                for (int i = 0; i < 8; ++i) { const int id = tid + NTHREADS * i; const int slot = (62 + 32 * tile + (id >> 7)) & 63;
                    *(LAS u32x4*)(lds + slot * 2048 + (id & 127) * 16) = pf[i]; }
                __syncthreads();
            }
        }
    }
}

template <bool FIRST>
__device__ __forceinline__ void resid_phase(const float* xin, const bf16_t* xinb, const bf16_t* y, const float* gpost, float* xout, bf16_t* x1b, bf16_t* xn, int lane, int gw, int NGW) {
    f32x4 gp[4];
#pragma unroll
    for (int j = 0; j < 4; ++j) gp[j] = ((const f32x4*)gpost)[lane + 64 * j];
    for (int m0 = gw; m0 < MTOK; m0 += NRF * NGW) {
        f32x4 xv[NRF][4], yv[NRF][4]; float s[NRF];
#pragma unroll
        for (int rr = 0; rr < NRF; ++rr) s[rr] = 0.f;
#pragma unroll
        for (int rr = 0; rr < NRF; ++rr) { const int m = m0 + rr * NGW; if (m < MTOK) {
            const u32x2* yr = (const u32x2*)(y + (size_t)m * DM) + lane;
            if (FIRST) { const f32x4* xr = (const f32x4*)(xin + (size_t)m * DM) + lane;
#pragma unroll
                for (int j = 0; j < 4; ++j) xv[rr][j] = __builtin_nontemporal_load(xr + 64 * j); }
            else { const u32x2* xr = (const u32x2*)(xinb + (size_t)m * DM) + lane;
#pragma unroll
                for (int j = 0; j < 4; ++j) { const u32x2 u = __builtin_nontemporal_load(xr + 64 * j); xv[rr][j] = (f32x4){bflo(u.x), bfhi(u.x), bflo(u.y), bfhi(u.y)}; } }
#pragma unroll
            for (int j = 0; j < 4; ++j) { const u32x2 u = __builtin_nontemporal_load(yr + 64 * j); yv[rr][j] = (f32x4){bflo(u.x), bfhi(u.x), bflo(u.y), bfhi(u.y)}; } } }
#pragma unroll
        for (int rr = 0; rr < NRF; ++rr) { const int m = m0 + rr * NGW; if (m < MTOK) {
#pragma unroll
            for (int j = 0; j < 4; ++j) s[rr] += (yv[rr][j].x * yv[rr][j].x + yv[rr][j].y * yv[rr][j].y) + (yv[rr][j].z * yv[rr][j].z + yv[rr][j].w * yv[rr][j].w);
            const float r = rsqrtf(wave_sum(s[rr]) * (1.f / DM) + EPS);
            float s1 = 0.f;
#pragma unroll
            for (int j = 0; j < 4; ++j) { xv[rr][j] = xv[rr][j] + yv[rr][j] * r * gp[j];
                s1 += (xv[rr][j].x * xv[rr][j].x + xv[rr][j].y * xv[rr][j].y) + (xv[rr][j].z * xv[rr][j].z + xv[rr][j].w * xv[rr][j].w); }
            if (FIRST) {
                const float r1 = rsqrtf(wave_sum(s1) * (1.f / DM) + EPS);
                u32x2* o8 = (u32x2*)(xn + (size_t)m * DM) + lane; u32x2* b8 = (u32x2*)(x1b + (size_t)m * DM) + lane;
#pragma unroll
                for (int j = 0; j < 4; ++j) { u32x2 w; w.x = pk2(xv[rr][j].x * r1, xv[rr][j].y * r1); w.y = pk2(xv[rr][j].z * r1, xv[rr][j].w * r1); o8[64 * j] = w;
                    u32x2 wb; wb.x = pk2(xv[rr][j].x, xv[rr][j].y); wb.y = pk2(xv[rr][j].z, xv[rr][j].w); b8[64 * j] = wb; }
            } else {
                f32x4* xo = (f32x4*)(xout + (size_t)m * DM) + lane;
#pragma unroll
                for (int j = 0; j < 4; ++j) __builtin_nontemporal_store(xv[rr][j], xo + 64 * j);
            } } }
    }
}
#define XB_TMO      128
#define XB_XCNT(j)  (256  + 64 * (j))
#define XB_XSUB(j)  (1280 + 64 * (j))
#define XB_XGEN(j)  (2304 + 64 * (j))
#define XB_TOP      3328
#define XB_TOPGEN   3392
#define XCD_BAR_WORDS 3456
#define XB_SPIN_CAP (1u << 18)

__device__ __forceinline__ unsigned xb_ld(unsigned* p)              { return __hip_atomic_load(p, __ATOMIC_RELAXED, __HIP_MEMORY_SCOPE_AGENT); }
__device__ __forceinline__ unsigned xb_add(unsigned* p, unsigned v) { return __hip_atomic_fetch_add(p, v, __ATOMIC_RELAXED, __HIP_MEMORY_SCOPE_AGENT); }
__device__ __forceinline__ unsigned xb_xcc_id() { return (unsigned)__builtin_amdgcn_s_getreg((3 << 11) | 20) & 0xFu; }
#define XB_SPIN(cond, bar) do { unsigned _sp = 0; while (cond) { __builtin_amdgcn_s_sleep(1); \
    if ((++_sp & 255u) == 0u) { if (xb_ld(&(bar)[XB_TMO])) break; if (_sp > XB_SPIN_CAP) { atomicAdd(&(bar)[XB_TMO], 1u); break; } } } } while (0)

struct XcdBarrier {
    unsigned* bar; unsigned x, nloc, nx;
};

__device__ __forceinline__ void xcd_barrier_complete(unsigned* bar, unsigned x, unsigned& nloc, unsigned& nx) {
    const unsigned G = gridDim.x * gridDim.y * gridDim.z;
    unsigned sum, cnt, mine, sp = 0u;
    for (;;) {
        sum = 0u; cnt = 0u; mine = 0u;
#pragma unroll
        for (unsigned j = 0; j < 16; ++j) { const unsigned c = xb_ld(&bar[XB_XCNT(j)]); sum += c; cnt += (c > 0u) ? 1u : 0u; mine = (j == x) ? c : mine; }
        if (sum == G) break;
        __builtin_amdgcn_s_sleep(1);
        if ((++sp & 255u) == 0u) { if (xb_ld(&bar[XB_TMO])) break; if (sp > XB_SPIN_CAP) { atomicAdd(&bar[XB_TMO], 1u); break; } }
    }
    nloc = mine > 0u ? mine : 1u; nx = cnt > 0u ? cnt : 1u;
}

__device__ __forceinline__ void xcd_barrier(const XcdBarrier& b) {
    asm volatile("s_waitcnt vmcnt(0)" ::: "memory");
    __syncthreads();
    if (threadIdx.x == 0) {
        unsigned* bar = b.bar;
        __builtin_amdgcn_s_waitcnt(0);
        const unsigned nloc = b.nloc, nx = b.nx;
        const unsigned old = xb_add(&bar[XB_XSUB(b.x)], 1u);
        const unsigned gen = old / nloc;
        if (old + 1u == (gen + 1u) * nloc) {
            __builtin_amdgcn_fence(__ATOMIC_RELEASE, "agent");
            asm volatile("s_waitcnt vmcnt(0)" ::: "memory");
            const unsigned og = xb_add(&bar[XB_TOP], 1u);
            const unsigned tg = og / nx;
            if (og + 1u == (tg + 1u) * nx) xb_add(&bar[XB_TOPGEN], 1u);
            else XB_SPIN(xb_ld(&bar[XB_TOPGEN]) == tg, bar);
            __builtin_amdgcn_fence(__ATOMIC_ACQUIRE, "agent");
            xb_add(&bar[XB_XGEN(b.x)], 1u);
            asm volatile("s_waitcnt vmcnt(0)" ::: "memory");
        } else {
            XB_SPIN(xb_ld(&bar[XB_XGEN(b.x)]) == gen, bar);
            __builtin_amdgcn_fence(__ATOMIC_ACQUIRE, "agent");
            asm volatile("s_waitcnt vmcnt(0)" ::: "memory");
        }
    }
    __syncthreads();
}
__device__ __forceinline__ XcdBarrier xcd_barrier_init(unsigned* bar, volatile LAS unsigned* tmp) {
    XcdBarrier b; b.bar = bar; b.x = xb_xcc_id();
    if (threadIdx.x == 0) { (void)xb_add(&bar[XB_XCNT(b.x)], 1u); unsigned nloc, nx; xcd_barrier_complete(bar, b.x, nloc, nx); tmp[0] = nloc; tmp[1] = nx; }
    __syncthreads();
    b.nloc = (unsigned)__builtin_amdgcn_readfirstlane((int)tmp[0]); b.nx = (unsigned)__builtin_amdgcn_readfirstlane((int)tmp[1]);
    __syncthreads();
    return b;
}


constexpr int KT_BYTES = 64 * 256, VT_BYTES = 128 * 128, NBUF = 3, LDS_VOFF = NBUF * KT_BYTES, LDS_QOFF = NBUF * (KT_BYTES + VT_BYTES);
typedef short v4i16_t __attribute__((ext_vector_type(4)));
__device__ __forceinline__ v4i16_t vtr16(const LAS unsigned char* p) { return __builtin_amdgcn_ds_read_tr16_b64_v4i16((LAS v4i16_t*)p); }
__device__ __forceinline__ int pi32(int i) { return (i & ~12) | ((i & 4) << 1) | ((i & 8) >> 1); }
__device__ __forceinline__ float hmax32(float v) { auto rr = __builtin_amdgcn_permlane32_swap(__float_as_uint(v), __float_as_uint(v), false, false); return fmaxf(__uint_as_float(rr[0]), __uint_as_float(rr[1])); }
__device__ __forceinline__ float hsum32(float v) { auto rr = __builtin_amdgcn_permlane32_swap(__float_as_uint(v), __float_as_uint(v), false, false); return __uint_as_float(rr[0]) + __uint_as_float(rr[1]); }

template <bool DIAG>
__device__ __forceinline__ void attn_sub(f32x16 (&O)[2][4], const LAS unsigned char* qlds, float (&mrun)[2], float (&lrun)[2],
                                         const LAS unsigned char* const (&kptr)[2][4], const LAS unsigned char* const (&vptr)[4][2], int koff, int voff, const f32x16& cinit, float cb, int j32, int hi, bool isdiag) {
    f32x16 x0, x1;
#pragma unroll
    for (int sh = 0; sh < 2; ++sh) {
        bf16x8 kf[2][2], qv[2][2];
#pragma unroll
        for (int c = 0; c < 2; ++c)
#pragma unroll
            for (int s2 = 0; s2 < 2; ++s2) { kf[c][s2] = *(const LAS bf16x8*)(kptr[c][sh * 2 + s2] + koff); qv[c][s2] = *(const LAS bf16x8*)(qlds + (c * 4 + sh * 2 + s2) * 1024); }
        if (sh == 0) {
            x0 = __builtin_amdgcn_mfma_f32_32x32x16_bf16(kf[0][0], qv[0][0], cinit, 0, 0, 0); x1 = __builtin_amdgcn_mfma_f32_32x32x16_bf16(kf[1][0], qv[1][0], cinit, 0, 0, 0);
            x0 = __builtin_amdgcn_mfma_f32_32x32x16_bf16(kf[0][1], qv[0][1], x0, 0, 0, 0); x1 = __builtin_amdgcn_mfma_f32_32x32x16_bf16(kf[1][1], qv[1][1], x1, 0, 0, 0);
        } else {
#pragma unroll
            for (int s2 = 0; s2 < 2; ++s2) { x0 = __builtin_amdgcn_mfma_f32_32x32x16_bf16(kf[0][s2], qv[0][s2], x0, 0, 0, 0); x1 = __builtin_amdgcn_mfma_f32_32x32x16_bf16(kf[1][s2], qv[1][s2], x1, 0, 0, 0); }
        }
        __builtin_amdgcn_sched_barrier(0);
    }
    if (isdiag) {
#pragma unroll
        for (int r = 0; r < 16; ++r) { const int kk = 16 * (r >> 3) + 8 * hi + (r & 7); if (kk > j32) { x0[r] = -INFINITY; x1[r] = -INFINITY; } } }
    float mx0 = fmaxf(x0[0], x0[1]), mx1 = fmaxf(x1[0], x1[1]);
#pragma unroll
    for (int r = 2; r < 16; r += 2) { mx0 = fmaxf(fmaxf(mx0, x0[r]), x0[r + 1]); mx1 = fmaxf(fmaxf(mx1, x1[r]), x1[r + 1]); }
    const float mc0 = hmax32(mx0) + cb, mc1 = hmax32(mx1) + cb;
    if (__any((mc0 > mrun[0] + 8.f) || (mc1 > mrun[1] + 8.f))) {
        const float mn0 = fmaxf(mrun[0], mc0), al0 = __builtin_amdgcn_exp2f(mrun[0] - mn0), mn1 = fmaxf(mrun[1], mc1), al1 = __builtin_amdgcn_exp2f(mrun[1] - mn1);
        lrun[0] *= al0; lrun[1] *= al1; mrun[0] = mn0; mrun[1] = mn1;
#pragma unroll
        for (int dt = 0; dt < 4; ++dt)
#pragma unroll
            for (int r = 0; r < 16; ++r) { O[0][dt][r] *= al0; O[1][dt][r] *= al1; }
    }
    const float off0 = cb - mrun[0], off1 = cb - mrun[1];
    float ls0 = 0.f, ls1 = 0.f;
#pragma unroll
    for (int r = 0; r < 16; ++r) { x0[r] = __builtin_amdgcn_exp2f(x0[r] + off0); ls0 += x0[r]; x1[r] = __builtin_amdgcn_exp2f(x1[r] + off1); ls1 += x1[r]; }
    lrun[0] += ls0; lrun[1] += ls1;
    bf16x8 p0[2], p1[2];
#pragma unroll
    for (int t = 0; t < 2; ++t) {
        p0[t] = __builtin_bit_cast(bf16x8, (u32x4){pk2(x0[8 * t], x0[8 * t + 1]), pk2(x0[8 * t + 2], x0[8 * t + 3]), pk2(x0[8 * t + 4], x0[8 * t + 5]), pk2(x0[8 * t + 6], x0[8 * t + 7])});
        p1[t] = __builtin_bit_cast(bf16x8, (u32x4){pk2(x1[8 * t], x1[8 * t + 1]), pk2(x1[8 * t + 2], x1[8 * t + 3]), pk2(x1[8 * t + 4], x1[8 * t + 5]), pk2(x1[8 * t + 6], x1[8 * t + 7])}); }
#pragma unroll
    for (int dt = 0; dt < 4; ++dt) {
        bf16x8 vf[2];
#pragma unroll
        for (int t = 0; t < 2; ++t) { const v4i16_t lo_ = vtr16(vptr[dt][0] + voff + t * 4096), hi_ = vtr16(vptr[dt][1] + voff + t * 4096);
            vf[t] = (bf16x8){lo_[0], lo_[1], lo_[2], lo_[3], hi_[0], hi_[1], hi_[2], hi_[3]}; }
#pragma unroll
        for (int t = 0; t < 2; ++t) {
            O[0][dt] = __builtin_amdgcn_mfma_f32_32x32x16_bf16(vf[t], p0[t], O[0][dt], 0, 0, 0);
            O[1][dt] = __builtin_amdgcn_mfma_f32_32x32x16_bf16(vf[t], p1[t], O[1][dt], 0, 0, 0); }
    }
}

__device__ __forceinline__ void attn_unit(LAS unsigned char* lds, int b, int h, int qb, const bf16_t* Qb, const bf16_t* Kb, const bf16_t* VT, const bf16_t* Zs, bf16_t* og,
                                          const float* gsub, float lam) {
    const int tid = threadIdx.x, lane = tid & 63, j32 = lane & 31, hi = lane >> 5; const int wid = __builtin_amdgcn_readfirstlane(tid >> 6);
    const float sl2 = exp2f(-(float)(h + 1)) * LOG2E;
    const size_t tokbase = (size_t)b * SEQ;
    const int q0w = qb * 256 + wid * 32, qpos = q0w + j32;
    LAS unsigned char* qlds = lds + LDS_QOFF + wid * 8192 + lane * 16;
    { const bf16_t* qp = Qb + (tokbase + qpos) * 1024 + h * 128 + hi * 8;
#pragma unroll
      for (int c = 0; c < 2; ++c)
#pragma unroll
          for (int s = 0; s < 4; ++s) *(LAS bf16x8*)(qlds + (c * 4 + s) * 1024) = *(const bf16x8*)(qp + c * 64 + s * 16); }
    f32x16 O[2][4];
#pragma unroll
    for (int c = 0; c < 2; ++c)
#pragma unroll
        for (int dt = 0; dt < 4; ++dt)
#pragma unroll
            for (int r = 0; r < 16; ++r) O[c][dt][r] = 0.f;
    float mrun[2] = {-1e30f, -1e30f}, lrun[2] = {0.f, 0.f};
    f32x16 cinit;
    { int hio = hi; asm volatile("" : "+v"(hio));
#pragma unroll
      for (int r = 0; r < 16; ++r) cinit[r] = sl2 * (float)(16 * (r >> 3) + 8 * hio + (r & 7)); }
    const int nsub_w = qb * 8 + wid + 1, NT = 4 * qb + 4;
    const bf16_t* Kbh = Kb + tokbase * 1024 + h * 128;
    const bf16_t* Vbh = VT + tokbase * 1024 + h * 128;
    unsigned kgo[2], vgo[2];
#pragma unroll
    for (int i = 0; i < 2; ++i) { const int kr = 4 * (2 * wid + i) + (lane >> 4), vr = 8 * (2 * wid + i) + (lane >> 3);
        kgo[i] = (unsigned)(kr * 1024 + (((lane & 15) ^ (kr & 15)) * 8)) * 2u;
        vgo[i] = (unsigned)(kr * 1024 + (((lane & 15) ^ (((kr & 3) << 2) | ((kr >> 2) & 3))) * 8)) * 2u; (void)vr; }
#define DMAT(kt, bf) do { const char* kb_ = (const char*)Kbh + (size_t)(unsigned)__builtin_amdgcn_readfirstlane((kt) * 131072); \
        const char* vb_ = (const char*)Vbh + (size_t)(unsigned)__builtin_amdgcn_readfirstlane((kt) * 131072); \
        _Pragma("unroll") for (int i_ = 0; i_ < 2; ++i_) { \
        __builtin_amdgcn_global_load_lds((const unsigned*)(kb_ + kgo[i_]), (LAS unsigned*)(lds + (bf) * KT_BYTES + (2 * wid + i_) * 1024), 16, 0, 0); \
        __builtin_amdgcn_global_load_lds((const unsigned*)(vb_ + vgo[i_]), (LAS unsigned*)(lds + LDS_VOFF + (bf) * VT_BYTES + (2 * wid + i_) * 1024), 16, 0, 0); } } while (0)
    const int krow = pi32(j32);
    const int kbase = krow * 256 + (((krow & 15) ^ hi) << 4);
    const int vbase = j32 * 128 + ((((j32 >> 1) & 7) ^ hi) << 4);
    const LAS unsigned char* kptr[2][4]; const LAS unsigned char* vptr[4][2];
#pragma unroll
    for (int c = 0; c < 2; ++c)
#pragma unroll
        for (int s_ = 0; s_ < 4; ++s_) kptr[c][s_] = lds + (kbase ^ ((c * 8 + s_ * 2) << 4));
    {
      const int q_ = (lane >> 2) & 3, p_ = lane & 3, g_ = (lane >> 4) & 1;
#pragma unroll
      for (int dt = 0; dt < 4; ++dt)
#pragma unroll
          for (int h4 = 0; h4 < 2; ++h4) { const int row_ = 8 * hi + 4 * h4 + q_, f_ = (q_ << 2) | ((2 * hi + h4) & 3), ch_ = dt * 4 + g_ * 2 + (p_ >> 1);
              vptr[dt][h4] = lds + LDS_VOFF + 256 * row_ + 16 * (ch_ ^ f_) + 8 * (p_ & 1); } }
#define WAIT_BAR(N) asm volatile("s_waitcnt vmcnt(" #N ") lgkmcnt(0)\n\ts_barrier" ::: "memory")
    asm volatile("s_waitcnt vmcnt(0)" ::: "memory");
    DMAT(NT - 1, 0); DMAT(NT - 2, 1);
#pragma unroll 1
    for (int it0 = 0; it0 < NT; it0 += NBUF) {
#pragma unroll
        for (int buf = 0; buf < NBUF; ++buf) {
            const int it = it0 + buf;
            if (it < NT) {
                const int kt = NT - 1 - it;
                if (it + 1 < NT) WAIT_BAR(4); else WAIT_BAR(0);
                if (it + 2 < NT) DMAT(kt - 2, (buf + 2) % NBUF);
#pragma unroll
                for (int st = 1; st >= 0; --st) {
                    const int sub = 2 * kt + st;
                    if (sub < nsub_w) {
                        const float cb = sl2 * (float)(sub * 32 - qpos);
                        attn_sub<true>(O, qlds, mrun, lrun, kptr, vptr, buf * KT_BYTES + st * 8192, buf * VT_BYTES + st * 8192, cinit, cb, j32, hi, sub == nsub_w - 1);
                    }
                }
            }
        }
    }
    asm volatile("s_waitcnt lgkmcnt(0)\n\ts_barrier" ::: "memory");
#undef WAIT_BAR
#undef DMAT
    const float inv0 = 1.f / hsum32(lrun[0]), k1 = -lam / hsum32(lrun[1]);
    float ss = 0.f;
#pragma unroll
    for (int dt = 0; dt < 4; ++dt)
#pragma unroll
        for (int r = 0; r < 16; ++r) { const float o = O[0][dt][r] * inv0 + O[1][dt][r] * k1; O[0][dt][r] = o; ss += o * o; }
    const float rs = rsqrtf(hsum32(ss) * (1.f / 128.f) + EPS) * (1.f - LAM_INIT);
    int hie = hi, qpe = qpos; asm volatile("" : "+v"(hie), "+v"(qpe));
    const size_t orow = (tokbase + qpe) * 1024 + h * 128;
#pragma unroll
    for (int dt = 0; dt < 4; ++dt)
#pragma unroll
        for (int rq = 0; rq < 4; ++rq) { const int dv = 32 * dt + 8 * rq + 4 * hie;
            const f32x4 gs = *(const f32x4*)(gsub + dv); const u32x2 zz = *(const u32x2*)(Zs + orow + dv);
            u32x2 w; w.x = pk2(O[0][dt][4 * rq] * rs * gs.x * bflo(zz.x), O[0][dt][4 * rq + 1] * rs * gs.y * bfhi(zz.x));
            w.y = pk2(O[0][dt][4 * rq + 2] * rs * gs.z * bflo(zz.y), O[0][dt][4 * rq + 3] * rs * gs.w * bfhi(zz.y));
            *(u32x2*)(og + orow + dv) = w; }
}

__device__ __forceinline__ void attn_phase(LAS unsigned char* lds, const bf16_t* Qb, const bf16_t* Kb, const bf16_t* VT, const bf16_t* Zs, bf16_t* og, const float* gsub, float lam) {
    for (int vb = blockIdx.x; vb < 256; vb += gridDim.x) {
        const int bh = vb & 127, half = vb >> 7;
#pragma unroll 1
        for (int ui = 0; ui < 4; ++ui) {
            const int qb = half == 0 ? (ui == 0 ? 7 : ui == 1 ? 0 : ui == 2 ? 5 : 2) : (ui == 0 ? 6 : ui == 1 ? 1 : ui == 2 ? 4 : 3);
            attn_unit(lds, bh >> 3, bh & 7, qb, Qb, Kb, VT, Zs, og, gsub, lam);
        }
    }
}

#ifndef REP_PH
#define REP_PH -1
#endif
#ifndef REP_N
#define REP_N 1
#endif
#define NREP(k) ((k) == REP_PH ? REP_N : 1)
#ifndef N_CG_SYNC
#define N_CG_SYNC 0
#endif
#ifndef MK_MULTI
#define MK_MULTI 0
#endif
__global__ void __launch_bounds__(NTHREADS, 2) yoco_fwd(Args a) {
    extern __shared__ __attribute__((aligned(16))) unsigned char lds_raw[];
    LAS unsigned char* lds = (LAS unsigned char*)lds_raw;
    cg::grid_group grid = cg::this_grid();
    const int tid = threadIdx.x, lane = tid & 63, wave = __builtin_amdgcn_readfirstlane(tid >> 6);
    const int lo = a.ph_lo, hi = a.ph_hi;
    const XcdBarrier xbar = xcd_barrier_init((unsigned*)(a.ws + WS_CTL), (volatile LAS unsigned*)lds);
    unsigned char* ws = a.ws;
    bf16_t* SA = (bf16_t*)(ws + WS_A); bf16_t* SB = (bf16_t*)(ws + WS_B); bf16_t* SC = (bf16_t*)(ws + WS_C); bf16_t* SF = (bf16_t*)(ws + WS_F); bf16_t* SG = (bf16_t*)(ws + WS_G); bf16_t* SH = (bf16_t*)(ws + WS_H);
#define IN(k) (lo <= (k) && (k) < hi)
#define SEAM(k) do { if (IN(k) && IN((k) + 1)) { if ((k) < N_CG_SYNC) grid.sync(); else xcd_barrier(xbar); } } while (0)
    if (lo > hi) grid.sync();
    if (IN(0)) { for (int rep = 0; rep < NREP(0); ++rep) p0_phase(a, lds, lane, wave); }
    SEAM(0);
    if (IN(1)) {
        pg8::Gemm g{SA, (const bf16_t*)(ws + WS_WT1), MTOK, 3072, 1024}; pg8::StaticOrder S; S.init(MTOK, 3072, gridDim.x, blockIdx.x); S.rep = NREP(1);
        pg8::EpiGlu E{SB, SC};
        pg8::gemm_phase<pg8::EpiGlu, pg8::StaticOrder, true, true>(lds, g, S, E);
    }
    SEAM(1);
    if (IN(2)) { for (int rep = 0; rep < NREP(2); ++rep) conv_phase(lds, SB, SC, SA, a.in[3], a.in[4], a.in[5], a.in[6]); }
    SEAM(2);
    if (IN(3)) {
        pg8::Gemm g{SA, (const bf16_t*)(ws + WS_WT2), MTOK, 1024, 1024}; pg8::StaticOrder S; S.init(MTOK, 1024, gridDim.x, blockIdx.x); S.rep = NREP(3);
        pg8::EpiPlain E{SB, 1024, 1.f};
        pg8::gemm_phase<pg8::EpiPlain, pg8::StaticOrder, true, true>(lds, g, S, E);
    }
    SEAM(3);
    if (IN(4)) {
        constexpr int NR4 = NWAVES - P4_NWT;
        if (wave >= NR4) late_weights(a, lds, lane, wave - NR4, P4_NWT);
        else resid_phase<true>(a.in[0], nullptr, SB, a.in[8], nullptr, SH, SA, lane, (int)blockIdx.x * NR4 + wave, (int)gridDim.x * NR4);
    }
    SEAM(4);
    if (IN(5)) {
        {
            static_assert(WS_WT3V == WS_WT3 + (size_t)3072 * 1024 * 2 && WS_G - WS_F == WS_C - WS_B, "K|Q|Z|V weights contiguous, output slots equally spaced");
            pg8::Gemm g{SA, (const bf16_t*)(ws + WS_WT3), MTOK, 4096, 1024}; pg8::StaticOrder S; S.init(MTOK, 4096, gridDim.x, blockIdx.x); S.rep = NREP(5);
            pg8::EpiKQZ E{SB, (size_t)(WS_C - WS_B) / 2, 0.125f * LOG2E};   static_assert(WS_C - WS_B == WS_F - WS_C, "K|Q|Z slots equally spaced");
            pg8::gemm_phase<pg8::EpiKQZ, pg8::StaticOrder, true, true>(lds, g, S, E);
        }
    }
    SEAM(5);
    if (IN(6)) {
        const float* lp = a.in[13];
        const float sa = wave_sum(lp[lane] * lp[64 + lane]), sb = wave_sum(lp[128 + lane] * lp[192 + lane]);
        const float lam = expf(sa) - expf(sb) + LAM_INIT;
        for (int rep = 0; rep < NREP(6); ++rep) attn_phase(lds, SC, SB, SG, SF, SA, a.in[14], lam);
    }
    SEAM(6);
    if (IN(7)) {
        pg8::Gemm g{SA, (const bf16_t*)(ws + WS_WT4), MTOK, 1024, 1024}; pg8::StaticOrder S; S.init(MTOK, 1024, gridDim.x, blockIdx.x);
        pg8::EpiPlain E{SB, 1024, 1.f};
        pg8::gemm_phase<pg8::EpiPlain, pg8::StaticOrder, true, true>(lds, g, S, E);
    }
    SEAM(7);
    if (IN(8)) { resid_phase<false>(nullptr, SH, SB, a.in[16], a.out, nullptr, nullptr, lane, (int)blockIdx.x * NWAVES + wave, (int)gridDim.x * NWAVES); }
#undef IN
#undef SEAM
}

extern "C" void kernel_launch(void* const* d_in, const int* in_sizes, int n_in, void* d_out, int out_size, void* d_ws, size_t ws_size, hipStream_t stream) {
    static int grid = 0;
    if (grid == 0) {
        if (n_in != 17 || in_sizes[0] != MTOK * DM || out_size != MTOK * DM || ws_size < WS_END) {
            fprintf(stderr, "kernel_launch: unexpected shapes (n_in %d in0 %d out %d ws %zu)\n", n_in, n_in > 0 ? in_sizes[0] : -1, out_size, ws_size); grid = -1; return; }
        int dev = 0, cus = 0, per_cu = 0;
        hipGetDevice(&dev);
        hipDeviceGetAttribute(&cus, hipDeviceAttributeMultiprocessorCount, dev);
        if (hipFuncSetAttribute((const void*)yoco_fwd, hipFuncAttributeMaxDynamicSharedMemorySize, LDS_BYTES) != hipSuccess) fprintf(stderr, "kernel_launch: hipFuncSetAttribute failed\n");
        if (hipOccupancyMaxActiveBlocksPerMultiprocessor(&per_cu, (const void*)yoco_fwd, NTHREADS, LDS_BYTES) != hipSuccess || per_cu < 1) {
            fprintf(stderr, "kernel_launch: occupancy query says %d blocks/CU\n", per_cu); per_cu = 1; }
        (void)hipGetLastError();
        grid = cus * per_cu; if (grid > 256) grid = 256;
        fprintf(stderr, "kernel_launch: grid %d (cus %d, per_cu %d)\n", grid, cus, per_cu);
    }
    if (grid < 0) return;
    if (hipMemsetAsync((char*)d_ws + WS_CTL, 0, CTL_BYTES, stream) != hipSuccess) fprintf(stderr, "kernel_launch: memset of the barrier words failed\n");
    Args a{};
    for (int i = 0; i < 17; ++i) a.in[i] = (const float*)d_in[i];
    a.out = (float*)d_out; a.ws = (unsigned char*)d_ws;
#if MK_MULTI
    for (int p = 0; p < 9; ++p) { a.ph_lo = p; a.ph_hi = p + 1; hipLaunchKernelGGL(yoco_fwd, dim3(grid), dim3(NTHREADS), LDS_BYTES, stream, a); }
#else
    a.ph_lo = 0; a.ph_hi = 9;
    void* args[] = {&a};
    hipError_t e = hipLaunchCooperativeKernel((const void*)yoco_fwd, dim3(grid), dim3(NTHREADS), args, LDS_BYTES, stream);
    if (e != hipSuccess) fprintf(stderr, "cooperative launch failed: %s (grid %d)\n", hipGetErrorString(e), grid);
#endif
}
```

```cpp
#include <hip/hip_runtime.h>
#include <hip/hip_cooperative_groups.h>
#include <cstdio>
#include <cstdint>
namespace cg = cooperative_groups;
namespace pg8 {
#define PG8_LAS __attribute__((address_space(3)))
typedef unsigned short bf16_t;
typedef short bf16x8 __attribute__((ext_vector_type(8)));
typedef float f32x4 __attribute__((ext_vector_type(4)));
typedef unsigned u32x4 __attribute__((ext_vector_type(4)));
constexpr int BM = 256, BK = 64, HALF = 128, HTB = HALF * BK * 2  , STAGE_BYTES = 8 * HTB, NXCD = 8, WGM = 8;

__host__ __device__ __forceinline__ int lds_byte(int r, int c) { const int st = (r >> 4) * 2 + (c >> 5), rr = r & 15, cc = c & 31, ob = rr * 64 + cc * 2; return st * 1024 + (ob ^ (((ob >> 9) & 1) << 5)); }
__host__ __device__ __forceinline__ void stage_rc(int b, int& R, int& C) { const int st = b / 1024, sb = b % 1024, swz = sb ^ (((sb >> 9) & 1) << 5); R = (st >> 1) * 16 + swz / 64; C = (st & 1) * 32 + (swz % 64) / 2; }
__host__ __device__ __forceinline__ int perm32(int rho) { const int n = rho >> 4, i = rho & 15; return 8 * (i >> 2) + 4 * n + (i & 3); }

struct Unit { int pm, pn; };
struct Gemm { const bf16_t* A; const bf16_t* Bt; int M, N, K; };

struct StaticOrder {
    int nM, nN, nwg, G, c, rep = 1;
    __host__ __device__ void init(int M, int N, int G_, int c_) { nM = M / BM; nN = N / BM; nwg = nM * nN; G = G_; c = c_; }
    __host__ __device__ bool next(int i, Unit& u) const {
        long L = (long)i * G + c; if (L >= (long)nwg * rep) return false;
        if (L >= nwg) L -= nwg;
        int wgid = (int)L; { const int q = nwg / NXCD, r = nwg % NXCD, xcd = wgid % NXCD, off = wgid / NXCD; wgid = (xcd < r ? xcd * (q + 1) : r * (q + 1) + (xcd - r) * q) + off; }
        const int nig = WGM * nN, gid = wgid / nig, fm = gid * WGM, gsz = (nM - fm) < WGM ? (nM - fm) : WGM;
        u.pm = fm + ((wgid % nig) % gsz); u.pn = (wgid % nig) / gsz; return true;
    }
    __device__ __forceinline__ void a_ready(const Unit&) const {}
    __device__ __forceinline__ void done(const Unit&) const {}
};

typedef float f32x2 __attribute__((ext_vector_type(2)));
typedef __bf16 bf16x2c __attribute__((ext_vector_type(2)));
__device__ __forceinline__ unsigned cvt_pk_bf16(float lo, float hi) { const f32x2 v = {lo, hi}; const bf16x2c b = __builtin_convertvector(v, bf16x2c); return __builtin_bit_cast(unsigned, b); }
template <class Epi, class Sched, bool ALIGN_EPI = false, bool SP2 = false>
__device__ __forceinline__ void gemm_phase(PG8_LAS unsigned char* lds, const Gemm g, const Sched& S, const Epi& E) {
    const int tid = threadIdx.x, wid = __builtin_amdgcn_readfirstlane(tid >> 6), lane = tid & 63, wr = wid >> 2, wc = wid & 3, fr = lane & 15, fq = lane >> 4;
    const int K = g.K, nt = K / BK;
    unsigned voffA[2], voffB[2];
#pragma unroll
    for (int i = 0; i < 2; ++i) { int R, C; stage_rc(tid * 16 + i * 8192, R, C); const int Rb = Epi::PERM ? ((R & ~31) + perm32(R & 31)) : R;
        voffA[i] = (unsigned)(R * K + C) * 2u; voffB[i] = (unsigned)(Rb * K + C) * 2u; }
    const size_t kstep = (size_t)(BK * 2);
    const size_t hstep = (size_t)HALF * K * 2;
    const size_t tstep = 2 * hstep;
    const unsigned ldsw = (unsigned)wid * 1024u;
    const int aoff = lds_byte(wr * 64 + fr, fq * 8), boff = lds_byte(wc * 32 + fr, fq * 8);
#define PG8_SA(b, h) (((b) * 2 + (h)) * HTB)
#define PG8_SB(b, h) ((4 + (b) * 2 + (h)) * HTB)
#define PG8_STAGE(bufoff, gbase, voff) do { _Pragma("unroll") for (int _i = 0; _i < 2; ++_i) \
        __builtin_amdgcn_global_load_lds((const unsigned*)((const char*)(gbase) + (voff)[_i]), (PG8_LAS unsigned*)(lds + (bufoff) + ldsw + _i * 8192), 16, 0, 0); } while (0)
#define PG8_LDA(dst, b, h) do { _Pragma("unroll") for (int m = 0; m < 4; ++m) _Pragma("unroll") for (int k = 0; k < 2; ++k) dst[m][k] = *(const PG8_LAS bf16x8*)(lds + PG8_SA(b, h) + aoff + m * 2048 + k * 1024); } while (0)
#define PG8_LDB(dst, b, h) do { _Pragma("unroll") for (int n = 0; n < 2; ++n) _Pragma("unroll") for (int k = 0; k < 2; ++k) dst[n][k] = *(const PG8_LAS bf16x8*)(lds + PG8_SB(b, h) + boff + n * 2048 + k * 1024); } while (0)
#define PG8_MMA(ai, bj, At, Bt) do { __builtin_amdgcn_s_setprio(1); _Pragma("unroll") for (int m = 0; m < 4; ++m) _Pragma("unroll") for (int n = 0; n < 2; ++n) _Pragma("unroll") for (int k = 0; k < 2; ++k) \
        acc[ai][bj][m][n] = __builtin_amdgcn_mfma_f32_16x16x32_bf16(Bt[n][k], At[m][k], acc[ai][bj][m][n], 0, 0, 0); __builtin_amdgcn_s_setprio(0); } while (0)
#define PG8_WAIT_V(n) asm volatile("s_waitcnt vmcnt(" #n ")" ::: "memory")
#define PG8_WAIT_L(n) asm volatile("s_waitcnt lgkmcnt(" #n ")" ::: "memory")
#define PG8_BAR __builtin_amdgcn_s_barrier()
#define PG8_SCHED __builtin_amdgcn_sched_barrier(0)
    Unit cur, nxt; int ui = 0;
    if (!S.next(0, cur)) return;
    f32x4 acc[2][2][4][2];
#pragma unroll
    for (int a = 0; a < 2; ++a)
#pragma unroll
        for (int b = 0; b < 2; ++b)
#pragma unroll
            for (int m = 0; m < 4; ++m)
#pragma unroll
                for (int n = 0; n < 2; ++n) acc[a][b][m][n] = (f32x4){0.f, 0.f, 0.f, 0.f};
    bf16x8 At[4][2], B0[2][2], B1[2][2];
    const char* cA = (const char*)g.A + (size_t)cur.pm * tstep; const char* cB = (const char*)g.Bt + (size_t)cur.pn * tstep;
    S.a_ready(cur);
    if constexpr (SP2) {
        PG8_STAGE(PG8_SB(0, 0), cB, voffB); PG8_STAGE(PG8_SB(0, 1), cB + hstep, voffB); PG8_STAGE(PG8_SA(0, 0), cA, voffA); PG8_STAGE(PG8_SA(0, 1), cA + hstep, voffA);
        if (wr == 1) PG8_BAR;
        PG8_WAIT_V(2); PG8_BAR;
        PG8_STAGE(PG8_SB(1, 0), cB + kstep, voffB); PG8_STAGE(PG8_SA(1, 0), cA + kstep, voffA); PG8_STAGE(PG8_SB(1, 1), cB + hstep + kstep, voffB);
        PG8_WAIT_V(6); PG8_BAR;
    } else {
        PG8_STAGE(PG8_SB(0, 0), cB, voffB); PG8_STAGE(PG8_SA(0, 0), cA, voffA); PG8_STAGE(PG8_SB(0, 1), cB + hstep, voffB); PG8_STAGE(PG8_SA(0, 1), cA + hstep, voffA);
        if (wr == 1) PG8_BAR;
        PG8_WAIT_V(4); PG8_BAR;
        PG8_STAGE(PG8_SB(1, 0), cB + kstep, voffB); PG8_STAGE(PG8_SA(1, 0), cA + kstep, voffA); PG8_STAGE(PG8_SB(1, 1), cB + hstep + kstep, voffB);
        PG8_WAIT_V(6); PG8_BAR;
    }
    for (;;) {
        const bool has_next = S.next(ui + 1, nxt);
        const char* nA = has_next ? (const char*)g.A + (size_t)nxt.pm * tstep : cA; const char* nB = has_next ? (const char*)g.Bt + (size_t)nxt.pn * tstep : cB;
        for (int t = 0; t < nt; t += 2) {
            const bool last = (t == nt - 2);
            const char* a1 = cA + (size_t)(t + 1) * kstep;
            const char* a2 = last ? nA : cA + (size_t)(t + 2) * kstep; const char* b2 = last ? nB : cB + (size_t)(t + 2) * kstep;
            const char* a3 = a2 + kstep; const char* b3 = b2 + kstep;
            if (last && has_next) S.a_ready(nxt);
            if constexpr (SP2) {
            PG8_LDB(B0, 0, 0); PG8_LDB(B1, 0, 1); PG8_SCHED; PG8_LDA(At, 0, 0); PG8_STAGE(PG8_SA(1, 1), a1 + hstep, voffA);
            PG8_WAIT_V(8); PG8_WAIT_L(0); PG8_BAR; PG8_MMA(0, 0, At, B0); PG8_MMA(0, 1, At, B1); PG8_BAR; PG8_SCHED;
            PG8_LDA(At, 0, 1); PG8_STAGE(PG8_SB(0, 0), b2, voffB); PG8_STAGE(PG8_SB(0, 1), b2 + hstep, voffB); PG8_STAGE(PG8_SA(0, 0), a2, voffA);
            PG8_WAIT_V(8); PG8_WAIT_L(0); PG8_BAR; PG8_MMA(1, 0, At, B0); PG8_MMA(1, 1, At, B1); PG8_BAR; PG8_SCHED;
            PG8_LDB(B0, 1, 0); PG8_LDB(B1, 1, 1); PG8_SCHED; PG8_LDA(At, 1, 0); PG8_STAGE(PG8_SA(0, 1), a2 + hstep, voffA);
            PG8_WAIT_V(8); PG8_WAIT_L(0); PG8_BAR; PG8_MMA(0, 0, At, B0); PG8_MMA(0, 1, At, B1); PG8_BAR; PG8_SCHED;
            PG8_LDA(At, 1, 1); PG8_STAGE(PG8_SB(1, 0), b3, voffB); PG8_STAGE(PG8_SB(1, 1), b3 + hstep, voffB); PG8_STAGE(PG8_SA(1, 0), a3, voffA);
            PG8_WAIT_V(8); PG8_WAIT_L(0); PG8_BAR; PG8_MMA(1, 0, At, B0); PG8_MMA(1, 1, At, B1); PG8_BAR; PG8_SCHED;
            } else {
            PG8_LDB(B0, 0, 0); PG8_SCHED; PG8_LDA(At, 0, 0); PG8_STAGE(PG8_SA(1, 1), a1 + hstep, voffA);
            PG8_WAIT_L(8); PG8_BAR; PG8_WAIT_L(0); PG8_MMA(0, 0, At, B0); PG8_BAR; PG8_SCHED;
            PG8_LDB(B1, 0, 1); PG8_STAGE(PG8_SB(0, 0), b2, voffB);
            PG8_BAR; PG8_WAIT_L(0); PG8_MMA(0, 1, At, B1); PG8_BAR;
            PG8_LDA(At, 0, 1); PG8_STAGE(PG8_SA(0, 0), a2, voffA);
            PG8_BAR; PG8_WAIT_L(0); PG8_MMA(1, 0, At, B0); PG8_BAR; PG8_SCHED;
            PG8_STAGE(PG8_SB(0, 1), b2 + hstep, voffB);
            PG8_WAIT_V(6); PG8_BAR; PG8_MMA(1, 1, At, B1); PG8_BAR;
            PG8_LDB(B0, 1, 0); PG8_SCHED; PG8_LDA(At, 1, 0); PG8_STAGE(PG8_SA(0, 1), a2 + hstep, voffA);
            PG8_WAIT_L(8); PG8_BAR; PG8_WAIT_L(0); PG8_MMA(0, 0, At, B0); PG8_BAR; PG8_SCHED;
            PG8_LDB(B1, 1, 1); PG8_STAGE(PG8_SB(1, 0), b3, voffB);
            PG8_BAR; PG8_WAIT_L(0); PG8_MMA(0, 1, At, B1); PG8_BAR;
            PG8_LDA(At, 1, 1); PG8_STAGE(PG8_SA(1, 0), a3, voffA);
            PG8_BAR; PG8_WAIT_L(0); PG8_MMA(1, 0, At, B0); PG8_BAR; PG8_SCHED;
            PG8_STAGE(PG8_SB(1, 1), b3 + hstep, voffB);
            PG8_WAIT_V(6); PG8_BAR; PG8_MMA(1, 1, At, B1); PG8_BAR;
            }
        }
        if constexpr (ALIGN_EPI) { if (wr == 0) PG8_BAR; }
        if constexpr (!Epi::AFTER_DRAIN) { E(acc, cur, wr, wc, fr, fq); S.done(cur); }
        if (!has_next) break;
#pragma unroll
        for (int a = 0; a < 2; ++a)
#pragma unroll
            for (int b = 0; b < 2; ++b)
#pragma unroll
                for (int m = 0; m < 4; ++m)
#pragma unroll
                    for (int n = 0; n < 2; ++n) acc[a][b][m][n] = (f32x4){0.f, 0.f, 0.f, 0.f};
        cur = nxt; cA = nA; cB = nB; ++ui;
        if constexpr (ALIGN_EPI) { if (wr == 1) PG8_BAR; }
    }
    PG8_WAIT_V(0);
    if constexpr (!ALIGN_EPI) { if (wr == 0) PG8_BAR; }
    PG8_BAR;
    if constexpr (Epi::AFTER_DRAIN) { E.fused(acc, cur, wr, wc, fr, fq, lds, wid, lane); S.done(cur); }
#undef PG8_SA
#undef PG8_SB
#undef PG8_STAGE
#undef PG8_LDA
#undef PG8_LDB
#undef PG8_MMA
#undef PG8_WAIT_V
#undef PG8_WAIT_L
#undef PG8_BAR
#undef PG8_SCHED
}
}

namespace pg8 {
__device__ __forceinline__ float sigm(float v) { return __builtin_amdgcn_rcpf(1.f + __builtin_amdgcn_exp2f(-1.4426950408889634f * v)); }
struct EpiPlain {
    static constexpr bool PERM = true, AFTER_DRAIN = false;
    bf16_t* O; int ldc; float scale;
    __device__ __forceinline__ void operator()(const f32x4 (&acc)[2][2][4][2], const Unit& u, int wr, int wc, int fr, int fq) const {
        const int row0 = u.pm * BM + wr * 64 + fr, col0 = u.pn * BM + wc * 32 + 8 * fq;
#pragma unroll
        for (int ai = 0; ai < 2; ++ai)
#pragma unroll
            for (int m = 0; m < 4; ++m) { bf16_t* rowp = O + (size_t)(row0 + ai * HALF + m * 16) * ldc + col0;
#pragma unroll
                for (int bj = 0; bj < 2; ++bj) { const f32x4 v0 = acc[ai][bj][m][0] * scale, v1 = acc[ai][bj][m][1] * scale;
                    u32x4 w; w.x = cvt_pk_bf16(v0[0], v0[1]); w.y = cvt_pk_bf16(v0[2], v0[3]); w.z = cvt_pk_bf16(v1[0], v1[1]); w.w = cvt_pk_bf16(v1[2], v1[3]);
                    *(u32x4*)(rowp + bj * HALF) = w; } }
    }
};
struct EpiGlu {
    static constexpr bool PERM = true, AFTER_DRAIN = false;
    bf16_t* G; bf16_t* SZ;
    __device__ __forceinline__ void operator()(const f32x4 (&acc)[2][2][4][2], const Unit& u, int wr, int wc, int fr, int fq) const {
        const int row0 = u.pm * BM + wr * 64 + fr;
        if (u.pn < 8) {
            const int col0 = u.pn * HALF + wc * 32 + 8 * fq;
#pragma unroll
            for (int ai = 0; ai < 2; ++ai)
#pragma unroll
                for (int m = 0; m < 4; ++m) { bf16_t* rowp = G + (size_t)(row0 + ai * HALF + m * 16) * 1024 + col0;
                    f32x4 v0, v1;
#pragma unroll
                    for (int j = 0; j < 4; ++j) { v0[j] = acc[ai][0][m][0][j] * sigm(acc[ai][1][m][0][j]); v1[j] = acc[ai][0][m][1][j] * sigm(acc[ai][1][m][1][j]); }
                    u32x4 w; w.x = cvt_pk_bf16(v0[0], v0[1]); w.y = cvt_pk_bf16(v0[2], v0[3]); w.z = cvt_pk_bf16(v1[0], v1[1]); w.w = cvt_pk_bf16(v1[2], v1[3]);
                    *(u32x4*)rowp = w; }
        } else {
            const int col0 = (u.pn - 8) * BM + wc * 32 + 8 * fq;
#pragma unroll
            for (int ai = 0; ai < 2; ++ai)
#pragma unroll
                for (int m = 0; m < 4; ++m) { bf16_t* rowp = SZ + (size_t)(row0 + ai * HALF + m * 16) * 1024 + col0;
#pragma unroll
                    for (int bj = 0; bj < 2; ++bj) { f32x4 v0 = acc[ai][bj][m][0], v1 = acc[ai][bj][m][1];
#pragma unroll
                        for (int j = 0; j < 4; ++j) { v0[j] = v0[j] * sigm(v0[j]); v1[j] = v1[j] * sigm(v1[j]); }
                        u32x4 w; w.x = cvt_pk_bf16(v0[0], v0[1]); w.y = cvt_pk_bf16(v0[2], v0[3]); w.z = cvt_pk_bf16(v1[0], v1[1]); w.w = cvt_pk_bf16(v1[2], v1[3]);
                        *(u32x4*)(rowp + bj * HALF) = w; } }
        }
    }
};
struct EpiKQZ {
    static constexpr bool PERM = true, AFTER_DRAIN = false;
    bf16_t* Kb; size_t seg_stride; float qscale;
    __device__ __forceinline__ void operator()(const f32x4 (&acc)[2][2][4][2], const Unit& u, int wr, int wc, int fr, int fq) const {
        const int row0 = u.pm * BM + wr * 64 + fr; const int seg = u.pn >> 2;
        bf16_t* base = Kb + (size_t)seg * seg_stride;
        const float sc = seg == 1 ? qscale : 1.f;
        const int col0 = (u.pn & 3) * BM + wc * 32 + 8 * fq;
#pragma unroll
        for (int ai = 0; ai < 2; ++ai)
#pragma unroll
            for (int m = 0; m < 4; ++m) { bf16_t* rowp = base + (size_t)(row0 + ai * HALF + m * 16) * 1024 + col0;
#pragma unroll
                for (int bj = 0; bj < 2; ++bj) { f32x4 v0 = acc[ai][bj][m][0] * sc, v1 = acc[ai][bj][m][1] * sc;
                    if (seg == 2) {
#pragma unroll
                        for (int j = 0; j < 4; ++j) { v0[j] = v0[j] * sigm(v0[j]); v1[j] = v1[j] * sigm(v1[j]); } }
                    u32x4 w; w.x = cvt_pk_bf16(v0[0], v0[1]); w.y = cvt_pk_bf16(v0[2], v0[3]); w.z = cvt_pk_bf16(v1[0], v1[1]); w.w = cvt_pk_bf16(v1[2], v1[3]);
                    *(u32x4*)(rowp + bj * HALF) = w; } }
    }
};
}

#define LAS __attribute__((address_space(3)))
typedef pg8::bf16_t bf16_t;
typedef pg8::bf16x8 bf16x8;
typedef pg8::f32x4 f32x4;
typedef pg8::u32x4 u32x4;
typedef float f32x16 __attribute__((ext_vector_type(16)));
typedef float f32x2v __attribute__((ext_vector_type(2)));
typedef unsigned u32x2 __attribute__((ext_vector_type(2)));

constexpr int BATCH = 16, SEQ = 2048, DM = 1024, MTOK = BATCH * SEQ;
constexpr int NH = 8, CK = 31;
constexpr float EPS = 1e-6f;
constexpr float LOG2E = 1.4426950408889634f;
constexpr float LAM_INIT = 0.4707130183435842f;
constexpr int NTHREADS = 512, NWAVES = 8;
constexpr int NRF0 = 8;
constexpr int NRF = 4;
constexpr int LDS_BYTES = 163840;
constexpr size_t MiB = 1u << 20;
constexpr size_t WS_WT1 = 0, WS_WT2 = 6 * MiB, WS_WT3 = 8 * MiB, WS_WT3V = 14 * MiB, WS_WT4 = 16 * MiB;
constexpr size_t WS_RS = 21 * MiB;
constexpr size_t WS_CTL = 20 * MiB, CTL_BYTES = 16384;
constexpr size_t WS_A = 32 * MiB, WS_B = 96 * MiB, WS_C = 160 * MiB, WS_F = 224 * MiB, WS_G = 288 * MiB, WS_H = 352 * MiB, WS_END = 416 * MiB;

struct Args { const float* in[17]; float* out; unsigned char* ws; int ph_lo, ph_hi; };

__device__ __forceinline__ float wave_sum(float v) {
#pragma unroll
    for (int o = 1; o < 64; o <<= 1) v += __shfl_xor(v, o);
    return v;
}
typedef __bf16 bf16x2_t __attribute__((ext_vector_type(2)));
__device__ __forceinline__ unsigned pk2(float lo, float hi) { const f32x2v v = {lo, hi}; const bf16x2_t b = __builtin_convertvector(v, bf16x2_t); return __builtin_bit_cast(unsigned, b); }
__device__ __forceinline__ float bflo(unsigned u) { return __builtin_bit_cast(float, u << 16); }
__device__ __forceinline__ float bfhi(unsigned u) { return __builtin_bit_cast(float, u & 0xffff0000u); }
#define LDS_WAIT() asm volatile("s_waitcnt lgkmcnt(0)" ::: "memory")

__device__ __forceinline__ void transpose_item(const float* W, int ldw, int col0, const float* gain, bf16_t* WT, int dst_row0, LAS float* scr, int kb, int lane) {
    const int k0 = 64 * kb;
    float wv[32];
#pragma unroll
    for (int i = 0; i < 32; ++i) { const int kk = 2 * i + (lane >> 5); wv[i] = W[(size_t)(k0 + kk) * ldw + col0 + (lane & 31)]; }
#pragma unroll
    for (int i = 0; i < 32; ++i) { const int kk = 2 * i + (lane >> 5); const float gg = gain ? gain[k0 + kk] : 1.f; scr[kk * 33 + (lane & 31)] = wv[i] * gg; }
    LDS_WAIT();
    const int c = lane & 7;
#pragma unroll
    for (int j = 0; j < 4; ++j) { const int n = (lane >> 3) + 8 * j; const LAS float* s = scr + (8 * c) * 33 + n;
        u32x4 o; o.x = pk2(s[0 * 33], s[1 * 33]); o.y = pk2(s[2 * 33], s[3 * 33]); o.z = pk2(s[4 * 33], s[5 * 33]); o.w = pk2(s[6 * 33], s[7 * 33]);
        *(u32x4*)(WT + (size_t)(dst_row0 + n) * 1024 + k0 + 8 * c) = o; }
    LDS_WAIT();
}

__device__ __forceinline__ void rms_row_to_bf16(const float* xrow, bf16_t* orow, int lane) {
    const f32x4* xr = (const f32x4*)xrow + lane;
    f32x4 v[4]; float s = 0.f;
#pragma unroll
    for (int j = 0; j < 4; ++j) { v[j] = xr[64 * j]; s += (v[j].x * v[j].x + v[j].y * v[j].y) + (v[j].z * v[j].z + v[j].w * v[j].w); }
    const float r = rsqrtf(wave_sum(s) * (1.f / DM) + EPS);
    u32x2* o8 = (u32x2*)orow + lane;
#pragma unroll
    for (int j = 0; j < 4; ++j) { u32x2 w; w.x = pk2(v[j].x * r, v[j].y * r); w.y = pk2(v[j].z * r, v[j].w * r); o8[64 * j] = w; }
}

__device__ __forceinline__ void p0_phase(const Args& a, LAS unsigned char* lds, int lane, int wave) {
    LAS float* scr = (LAS float*)(lds + wave * 16384);
    constexpr int NWT = 2, NWR = NWAVES - NWT;
    unsigned char* ws = a.ws;
    const bool is_tw = wave >= NWR;
    const int gw = is_tw ? blockIdx.x * NWT + (wave - NWR) : blockIdx.x * NWR + wave, NGW = is_tw ? gridDim.x * NWT : gridDim.x * NWR;
    if (is_tw)
    for (int it = gw; it < 9 * 512; it += NGW) {
        const int piece = it >> 9, r = it & 511, kb = r >> 5, cb = (r & 31) * 32;
        switch (piece) {
        case 0: transpose_item(a.in[2], 3072, cb, a.in[1], (bf16_t*)(ws + WS_WT1), (cb >> 7) * 256 + (cb & 127), scr, kb, lane); break;
        case 1: transpose_item(a.in[2], 3072, 1024 + cb, a.in[1], (bf16_t*)(ws + WS_WT1), (cb >> 7) * 256 + 128 + (cb & 127), scr, kb, lane); break;
        case 2: transpose_item(a.in[2], 3072, 2048 + cb, a.in[1], (bf16_t*)(ws + WS_WT1), 2048 + cb, scr, kb, lane); break;
        case 3: transpose_item(a.in[7], 1024, cb, nullptr, (bf16_t*)(ws + WS_WT2), cb, scr, kb, lane); break;
        case 4: transpose_item(a.in[10], 2048, cb, a.in[9], (bf16_t*)(ws + WS_WT3), cb, scr, kb, lane); break;
        case 5: transpose_item(a.in[10], 2048, 1024 + cb, a.in[9], (bf16_t*)(ws + WS_WT3V), cb, scr, kb, lane); break;
        case 6: transpose_item(a.in[12], 2048, cb, a.in[11], (bf16_t*)(ws + WS_WT3), 1024 + cb, scr, kb, lane); break;
        case 7: transpose_item(a.in[12], 2048, 1024 + cb, a.in[11], (bf16_t*)(ws + WS_WT3), 2048 + cb, scr, kb, lane); break;
        default: transpose_item(a.in[15], 1024, cb, nullptr, (bf16_t*)(ws + WS_WT4), cb, scr, kb, lane); break;
        }
    }
    bf16_t* xn0 = (bf16_t*)(ws + WS_A);
    if (!is_tw)
    for (int m0 = gw; m0 < MTOK; m0 += NRF0 * NGW) {
        f32x4 v[NRF0][4];
#pragma unroll
        for (int rr = 0; rr < NRF0; ++rr) { const int m = m0 + rr * NGW; if (m < MTOK) { const f32x4* xr = (const f32x4*)(a.in[0] + (size_t)m * DM) + lane;
#pragma unroll
            for (int j = 0; j < 4; ++j) v[rr][j] = __builtin_nontemporal_load(xr + 64 * j); } }
#pragma unroll
        for (int rr = 0; rr < NRF0; ++rr) { const int m = m0 + rr * NGW; if (m < MTOK) { float sq = 0.f;
#pragma unroll
            for (int j = 0; j < 4; ++j) sq += (v[rr][j].x * v[rr][j].x + v[rr][j].y * v[rr][j].y) + (v[rr][j].z * v[rr][j].z + v[rr][j].w * v[rr][j].w);
            const float r = rsqrtf(wave_sum(sq) * (1.f / DM) + EPS);
            u32x2* o8 = (u32x2*)(xn0 + (size_t)m * DM) + lane;
#pragma unroll
            for (int j = 0; j < 4; ++j) { u32x2 w; w.x = pk2(v[rr][j].x * r, v[rr][j].y * r); w.y = pk2(v[rr][j].z * r, v[rr][j].w * r); o8[64 * j] = w; } } }
    }
}

#define RS_STEP(N, MASK) { const bool up_ = (lane & (MASK)) != 0; _Pragma("unroll") for (int i_ = 0; i_ < (N) / 2; ++i_) { \
        const float keep_ = up_ ? rv[i_ + (N) / 2] : rv[i_], send_ = up_ ? rv[i_] : rv[i_ + (N) / 2]; rv[i_] = keep_ + __shfl_xor(send_, (MASK)); } }
__device__ __forceinline__ void conv_phase(LAS unsigned char* lds, const bf16_t* g, const bf16_t* sz, bf16_t* cgo,
                                           const float* wdw, const float* bdw, const float* lng, const float* lnb) {
    const int tid = threadIdx.x, lane = tid & 63, wave = tid >> 6;
    LAS float* red = (LAS float*)(lds + 131072);
    LAS float* stat = red + 128;
    f32x2v w[CK];
#pragma unroll
    for (int k = 0; k < CK; ++k) w[k] = *(const f32x2v*)(wdw + k * 1024 + 2 * tid);
    const f32x2v bb = *(const f32x2v*)(bdw + 2 * tid), lg = *(const f32x2v*)(lng + 2 * tid), lb = *(const f32x2v*)(lnb + 2 * tid);
    for (int chunk = blockIdx.x; chunk < MTOK / 128; chunk += gridDim.x) {
        const int c0 = chunk * 128, s0 = c0 & (SEQ - 1);
        __syncthreads();
        for (int id = tid; id < 62 * 128; id += NTHREADS) { const int row = id >> 7, ch = id & 127;
            u32x4 v = {0u, 0u, 0u, 0u};
            if (s0 - 30 + row >= 0) v = *(const u32x4*)(g + (size_t)(c0 - 30 + row) * 1024 + ch * 8);
            *(LAS u32x4*)(lds + row * 2048 + ch * 16) = v; }
        __syncthreads();
#pragma unroll 1
        for (int tile = 0; tile < 4; ++tile) {
            u32x4 pf[8];
            if (tile < 3) {
#pragma unroll
                for (int i = 0; i < 8; ++i) { const int id = tid + NTHREADS * i; pf[i] = __builtin_nontemporal_load((const u32x4*)(g + (size_t)(c0 + 32 + 32 * tile + (id >> 7)) * 1024 + (id & 127) * 8)); } }
#pragma unroll 1
            for (int gq = 0; gq < 4; ++gq) {
                const int rbase = (32 * tile + 8 * gq) & 63;
                f32x2v v[38];
#pragma unroll
                for (int i = 0; i < 38; ++i) { const int slot = (rbase + i) & 63; const unsigned u = *(const LAS unsigned*)(lds + slot * 2048 + tid * 4); v[i] = (f32x2v){bflo(u), bfhi(u)}; }
                unsigned zz[8];
#pragma unroll
                for (int tt = 0; tt < 8; ++tt) zz[tt] = *(const unsigned*)(sz + (size_t)(c0 + 32 * tile + gq * 8 + tt) * 1024 + 2 * tid);
                f32x2v cv[8];
#pragma unroll
                for (int tt = 0; tt < 8; ++tt) { f32x2v acc = bb;
#pragma unroll
                    for (int k = 0; k < CK; ++k) acc = __builtin_elementwise_fma(w[k], v[tt + k], acc);
                    cv[tt] = acc; }
                float rv[16];
#pragma unroll
                for (int tt = 0; tt < 8; ++tt) { rv[2 * tt] = cv[tt].x + cv[tt].y; rv[2 * tt + 1] = cv[tt].x * cv[tt].x + cv[tt].y * cv[tt].y; }
                RS_STEP(16, 32) RS_STEP(8, 16) RS_STEP(4, 8) RS_STEP(2, 4)
                rv[0] += __shfl_xor(rv[0], 2); rv[0] += __shfl_xor(rv[0], 1);
                if ((lane & 3) == 0) red[wave * 16 + (lane >> 2)] = rv[0];
                __syncthreads();
                if (tid < 8) { float s = 0.f, q = 0.f;
#pragma unroll
                    for (int ww = 0; ww < 8; ++ww) { s += red[ww * 16 + 2 * tid]; q += red[ww * 16 + 2 * tid + 1]; }
                    const float mu = s * (1.f / 1024.f), var = fmaxf(q * (1.f / 1024.f) - mu * mu, 0.f);
                    stat[2 * tid] = mu; stat[2 * tid + 1] = rsqrtf(var + EPS); }
                __syncthreads();
#pragma unroll
                for (int tt = 0; tt < 8; ++tt) { const float mu = stat[2 * tt], rs = stat[2 * tt + 1];
                    float n0 = (cv[tt].x - mu) * rs * lg.x + lb.x, n1 = (cv[tt].y - mu) * rs * lg.y + lb.y;
                    n0 = n0 * pg8::sigm(n0) * bflo(zz[tt]); n1 = n1 * pg8::sigm(n1) * bfhi(zz[tt]);
                    *(unsigned*)(cgo + (size_t)(c0 + 32 * tile + gq * 8 + tt) * 1024 + 2 * tid) = pk2(n0, n1); }
            }
            if (tile < 3) {
#pragma unroll
                for (int i = 0; i < 8; ++i) { const int id = tid + NTHREADS * i; const int slot = (62 + 32 * tile + (id >> 7)) & 63;
                    *(LAS u32x4*)(lds + slot * 2048 + (id & 127) * 16) = pf[i]; }
                __syncthreads();
            }
        }
    }
}

template <bool FIRST>
__device__ __forceinline__ void resid_phase(const float* xin, const bf16_t* xinb, const bf16_t* y, const float* gpost, float* xout, float* rscale, bf16_t* xn, int lane, int wave) {
    const int gw = blockIdx.x * NWAVES + wave, NGW = gridDim.x * NWAVES;
    f32x4 gp[4];
#pragma unroll
    for (int j = 0; j < 4; ++j) gp[j] = ((const f32x4*)gpost)[lane + 64 * j];
    for (int m0 = gw; m0 < MTOK; m0 += NRF * NGW) {
        f32x4 xv[NRF][4], yv[NRF][4]; float s[NRF];
#pragma unroll
        for (int rr = 0; rr < NRF; ++rr) s[rr] = 0.f;
#pragma unroll
        for (int rr = 0; rr < NRF; ++rr) { const int m = m0 + rr * NGW; if (m < MTOK) {
            const u32x2* yr = (const u32x2*)(y + (size_t)m * DM) + lane;
            if (FIRST) { const f32x4* xr = (const f32x4*)(xin + (size_t)m * DM) + lane;
#pragma unroll
                for (int j = 0; j < 4; ++j) xv[rr][j] = __builtin_nontemporal_load(xr + 64 * j); }
            else { const u32x2* xr = (const u32x2*)(xinb + (size_t)m * DM) + lane; const float rsc = rscale[m];
#pragma unroll
                for (int j = 0; j < 4; ++j) { const u32x2 u = __builtin_nontemporal_load(xr + 64 * j); xv[rr][j] = (f32x4){bflo(u.x), bfhi(u.x), bflo(u.y), bfhi(u.y)} * rsc; } }
#pragma unroll
            for (int j = 0; j < 4; ++j) { const u32x2 u = __builtin_nontemporal_load(yr + 64 * j); yv[rr][j] = (f32x4){bflo(u.x), bfhi(u.x), bflo(u.y), bfhi(u.y)}; } } }
#pragma unroll
        for (int rr = 0; rr < NRF; ++rr) { const int m = m0 + rr * NGW; if (m < MTOK) {
#pragma unroll
            for (int j = 0; j < 4; ++j) s[rr] += (yv[rr][j].x * yv[rr][j].x + yv[rr][j].y * yv[rr][j].y) + (yv[rr][j].z * yv[rr][j].z + yv[rr][j].w * yv[rr][j].w);
            const float r = rsqrtf(wave_sum(s[rr]) * (1.f / DM) + EPS);
            float s1 = 0.f;
#pragma unroll
            for (int j = 0; j < 4; ++j) { xv[rr][j] = xv[rr][j] + yv[rr][j] * r * gp[j];
                s1 += (xv[rr][j].x * xv[rr][j].x + xv[rr][j].y * xv[rr][j].y) + (xv[rr][j].z * xv[rr][j].z + xv[rr][j].w * xv[rr][j].w); }
            if (FIRST) {
                const float r1 = rsqrtf(wave_sum(s1) * (1.f / DM) + EPS);
                u32x2* o8 = (u32x2*)(xn + (size_t)m * DM) + lane;
                if (lane == 0) rscale[m] = 1.f / r1;
#pragma unroll
                for (int j = 0; j < 4; ++j) { u32x2 w; w.x = pk2(xv[rr][j].x * r1, xv[rr][j].y * r1); w.y = pk2(xv[rr][j].z * r1, xv[rr][j].w * r1); o8[64 * j] = w; }
            } else {
                f32x4* xo = (f32x4*)(xout + (size_t)m * DM) + lane;
#pragma unroll
                for (int j = 0; j < 4; ++j) __builtin_nontemporal_store(xv[rr][j], xo + 64 * j);
            } } }
    }
}
#define XB_TMO      128
#define XB_XCNT(j)  (256  + 64 * (j))
#define XB_XSUB(j)  (1280 + 64 * (j))
#define XB_XGEN(j)  (2304 + 64 * (j))
#define XB_TOP      3328
#define XB_TOPGEN   3392
#define XCD_BAR_WORDS 3456
#define XB_SPIN_CAP (1u << 18)

__device__ __forceinline__ unsigned xb_ld(unsigned* p)              { return __hip_atomic_load(p, __ATOMIC_RELAXED, __HIP_MEMORY_SCOPE_AGENT); }
__device__ __forceinline__ unsigned xb_add(unsigned* p, unsigned v) { return __hip_atomic_fetch_add(p, v, __ATOMIC_RELAXED, __HIP_MEMORY_SCOPE_AGENT); }
__device__ __forceinline__ unsigned xb_xcc_id() { return (unsigned)__builtin_amdgcn_s_getreg((3 << 11) | 20) & 0xFu; }
#define XB_SPIN(cond, bar) do { unsigned _sp = 0; while (cond) { __builtin_amdgcn_s_sleep(1); \
    if ((++_sp & 255u) == 0u) { if (xb_ld(&(bar)[XB_TMO])) break; if (_sp > XB_SPIN_CAP) { atomicAdd(&(bar)[XB_TMO], 1u); break; } } } } while (0)

struct XcdBarrier {
    unsigned* bar; unsigned x, nloc, nx;
};

__device__ __forceinline__ void xcd_barrier_complete(unsigned* bar, unsigned x, unsigned& nloc, unsigned& nx) {
    const unsigned G = gridDim.x * gridDim.y * gridDim.z;
    unsigned sum, cnt, mine, sp = 0u;
    for (;;) {
        sum = 0u; cnt = 0u; mine = 0u;
#pragma unroll
        for (unsigned j = 0; j < 16; ++j) { const unsigned c = xb_ld(&bar[XB_XCNT(j)]); sum += c; cnt += (c > 0u) ? 1u : 0u; mine = (j == x) ? c : mine; }
        if (sum == G) break;
        __builtin_amdgcn_s_sleep(1);
        if ((++sp & 255u) == 0u) { if (xb_ld(&bar[XB_TMO])) break; if (sp > XB_SPIN_CAP) { atomicAdd(&bar[XB_TMO], 1u); break; } }
    }
    nloc = mine > 0u ? mine : 1u; nx = cnt > 0u ? cnt : 1u;
}

__device__ __forceinline__ void xcd_barrier(const XcdBarrier& b) {
    asm volatile("s_waitcnt vmcnt(0)" ::: "memory");
    __syncthreads();
    if (threadIdx.x == 0) {
        unsigned* bar = b.bar;
        __builtin_amdgcn_s_waitcnt(0);
        const unsigned nloc = b.nloc, nx = b.nx;
        const unsigned old = xb_add(&bar[XB_XSUB(b.x)], 1u);
        const unsigned gen = old / nloc;
        if (old + 1u == (gen + 1u) * nloc) {
            __builtin_amdgcn_fence(__ATOMIC_RELEASE, "agent");
            asm volatile("s_waitcnt vmcnt(0)" ::: "memory");
            const unsigned og = xb_add(&bar[XB_TOP], 1u);
            const unsigned tg = og / nx;
            if (og + 1u == (tg + 1u) * nx) xb_add(&bar[XB_TOPGEN], 1u);
            else XB_SPIN(xb_ld(&bar[XB_TOPGEN]) == tg, bar);
            __builtin_amdgcn_fence(__ATOMIC_ACQUIRE, "agent");
            xb_add(&bar[XB_XGEN(b.x)], 1u);
            asm volatile("s_waitcnt vmcnt(0)" ::: "memory");
        } else {
            XB_SPIN(xb_ld(&bar[XB_XGEN(b.x)]) == gen, bar);
            __builtin_amdgcn_fence(__ATOMIC_ACQUIRE, "agent");
            asm volatile("s_waitcnt vmcnt(0)" ::: "memory");
        }
    }
    __syncthreads();
}
__device__ __forceinline__ XcdBarrier xcd_barrier_init(unsigned* bar, volatile LAS unsigned* tmp) {
    XcdBarrier b; b.bar = bar; b.x = xb_xcc_id();
    if (threadIdx.x == 0) { (void)xb_add(&bar[XB_XCNT(b.x)], 1u); unsigned nloc, nx; xcd_barrier_complete(bar, b.x, nloc, nx); tmp[0] = nloc; tmp[1] = nx; }
    __syncthreads();
    b.nloc = (unsigned)__builtin_amdgcn_readfirstlane((int)tmp[0]); b.nx = (unsigned)__builtin_amdgcn_readfirstlane((int)tmp[1]);
    __syncthreads();
    return b;
}


constexpr int KT_BYTES = 64 * 256, VT_BYTES = 128 * 128, NBUF = 3, LDS_VOFF = NBUF * KT_BYTES, LDS_QOFF = NBUF * (KT_BYTES + VT_BYTES);
typedef short v4i16_t __attribute__((ext_vector_type(4)));
__device__ __forceinline__ v4i16_t vtr16(const LAS unsigned char* p) { return __builtin_amdgcn_ds_read_tr16_b64_v4i16((LAS v4i16_t*)p); }
__device__ __forceinline__ int pi32(int i) { return (i & ~12) | ((i & 4) << 1) | ((i & 8) >> 1); }
__device__ __forceinline__ float hmax32(float v) { auto rr = __builtin_amdgcn_permlane32_swap(__float_as_uint(v), __float_as_uint(v), false, false); return fmaxf(__uint_as_float(rr[0]), __uint_as_float(rr[1])); }
__device__ __forceinline__ float hsum32(float v) { auto rr = __builtin_amdgcn_permlane32_swap(__float_as_uint(v), __float_as_uint(v), false, false); return __uint_as_float(rr[0]) + __uint_as_float(rr[1]); }

template <bool DIAG>
__device__ __forceinline__ void attn_sub(f32x16 (&O)[2][4], const LAS unsigned char* qlds, float (&mrun)[2], float (&lrun)[2],
                                         const LAS unsigned char* const (&kptr)[2][4], const LAS unsigned char* const (&vptr)[4][2], int koff, int voff, const f32x16& cinit, float cb, int j32, int hi, bool isdiag) {
    f32x16 x0, x1;
#pragma unroll
    for (int sh = 0; sh < 2; ++sh) {
        bf16x8 kf[2][2], qv[2][2];
#pragma unroll
        for (int c = 0; c < 2; ++c)
#pragma unroll
            for (int s2 = 0; s2 < 2; ++s2) { kf[c][s2] = *(const LAS bf16x8*)(kptr[c][sh * 2 + s2] + koff); qv[c][s2] = *(const LAS bf16x8*)(qlds + (c * 4 + sh * 2 + s2) * 1024); }
        if (sh == 0) {
            x0 = __builtin_amdgcn_mfma_f32_32x32x16_bf16(kf[0][0], qv[0][0], cinit, 0, 0, 0); x1 = __builtin_amdgcn_mfma_f32_32x32x16_bf16(kf[1][0], qv[1][0], cinit, 0, 0, 0);
            x0 = __builtin_amdgcn_mfma_f32_32x32x16_bf16(kf[0][1], qv[0][1], x0, 0, 0, 0); x1 = __builtin_amdgcn_mfma_f32_32x32x16_bf16(kf[1][1], qv[1][1], x1, 0, 0, 0);
        } else {
#pragma unroll
            for (int s2 = 0; s2 < 2; ++s2) { x0 = __builtin_amdgcn_mfma_f32_32x32x16_bf16(kf[0][s2], qv[0][s2], x0, 0, 0, 0); x1 = __builtin_amdgcn_mfma_f32_32x32x16_bf16(kf[1][s2], qv[1][s2], x1, 0, 0, 0); }
        }
        __builtin_amdgcn_sched_barrier(0);
    }
    if (isdiag) {
#pragma unroll
        for (int r = 0; r < 16; ++r) { const int kk = 16 * (r >> 3) + 8 * hi + (r & 7); if (kk > j32) { x0[r] = -INFINITY; x1[r] = -INFINITY; } } }
    float mx0 = fmaxf(x0[0], x0[1]), mx1 = fmaxf(x1[0], x1[1]);
#pragma unroll
    for (int r = 2; r < 16; r += 2) { mx0 = fmaxf(fmaxf(mx0, x0[r]), x0[r + 1]); mx1 = fmaxf(fmaxf(mx1, x1[r]), x1[r + 1]); }
    const float mc0 = hmax32(mx0) + cb, mc1 = hmax32(mx1) + cb;
    if (__any((mc0 > mrun[0] + 8.f) || (mc1 > mrun[1] + 8.f))) {
        const float mn0 = fmaxf(mrun[0], mc0), al0 = __builtin_amdgcn_exp2f(mrun[0] - mn0), mn1 = fmaxf(mrun[1], mc1), al1 = __builtin_amdgcn_exp2f(mrun[1] - mn1);
        lrun[0] *= al0; lrun[1] *= al1; mrun[0] = mn0; mrun[1] = mn1;
#pragma unroll
        for (int dt = 0; dt < 4; ++dt)
#pragma unroll
            for (int r = 0; r < 16; ++r) { O[0][dt][r] *= al0; O[1][dt][r] *= al1; }
    }
    const float off0 = cb - mrun[0], off1 = cb - mrun[1];
    float ls0 = 0.f, ls1 = 0.f;
#pragma unroll
    for (int r = 0; r < 16; ++r) { x0[r] = __builtin_amdgcn_exp2f(x0[r] + off0); ls0 += x0[r]; x1[r] = __builtin_amdgcn_exp2f(x1[r] + off1); ls1 += x1[r]; }
    lrun[0] += ls0; lrun[1] += ls1;
    bf16x8 p0[2], p1[2];
#pragma unroll
    for (int t = 0; t < 2; ++t) {
        p0[t] = __builtin_bit_cast(bf16x8, (u32x4){pk2(x0[8 * t], x0[8 * t + 1]), pk2(x0[8 * t + 2], x0[8 * t + 3]), pk2(x0[8 * t + 4], x0[8 * t + 5]), pk2(x0[8 * t + 6], x0[8 * t + 7])});
        p1[t] = __builtin_bit_cast(bf16x8, (u32x4){pk2(x1[8 * t], x1[8 * t + 1]), pk2(x1[8 * t + 2], x1[8 * t + 3]), pk2(x1[8 * t + 4], x1[8 * t + 5]), pk2(x1[8 * t + 6], x1[8 * t + 7])}); }
#pragma unroll
    for (int dt = 0; dt < 4; ++dt) {
        bf16x8 vf[2];
#pragma unroll
        for (int t = 0; t < 2; ++t) { const v4i16_t lo_ = vtr16(vptr[dt][0] + voff + t * 4096), hi_ = vtr16(vptr[dt][1] + voff + t * 4096);
            vf[t] = (bf16x8){lo_[0], lo_[1], lo_[2], lo_[3], hi_[0], hi_[1], hi_[2], hi_[3]}; }
#pragma unroll
        for (int t = 0; t < 2; ++t) {
            O[0][dt] = __builtin_amdgcn_mfma_f32_32x32x16_bf16(vf[t], p0[t], O[0][dt], 0, 0, 0);
            O[1][dt] = __builtin_amdgcn_mfma_f32_32x32x16_bf16(vf[t], p1[t], O[1][dt], 0, 0, 0); }
    }
}

__device__ __forceinline__ void attn_unit(LAS unsigned char* lds, int b, int h, int qb, const bf16_t* Qb, const bf16_t* Kb, const bf16_t* VT, const bf16_t* Zs, bf16_t* og,
                                          const float* gsub, float lam) {
    const int tid = threadIdx.x, lane = tid & 63, j32 = lane & 31, hi = lane >> 5; const int wid = __builtin_amdgcn_readfirstlane(tid >> 6);
    const float sl2 = exp2f(-(float)(h + 1)) * LOG2E;
    const size_t tokbase = (size_t)b * SEQ;
    const int q0w = qb * 256 + wid * 32, qpos = q0w + j32;
    LAS unsigned char* qlds = lds + LDS_QOFF + wid * 8192 + lane * 16;
    { const bf16_t* qp = Qb + (tokbase + qpos) * 1024 + h * 128 + hi * 8;
#pragma unroll
      for (int c = 0; c < 2; ++c)
#pragma unroll
          for (int s = 0; s < 4; ++s) *(LAS bf16x8*)(qlds + (c * 4 + s) * 1024) = *(const bf16x8*)(qp + c * 64 + s * 16); }
    f32x16 O[2][4];
#pragma unroll
    for (int c = 0; c < 2; ++c)
#pragma unroll
        for (int dt = 0; dt < 4; ++dt)
#pragma unroll
            for (int r = 0; r < 16; ++r) O[c][dt][r] = 0.f;
    float mrun[2] = {-1e30f, -1e30f}, lrun[2] = {0.f, 0.f};
    f32x16 cinit;
    { int hio = hi; asm volatile("" : "+v"(hio));
#pragma unroll
      for (int r = 0; r < 16; ++r) cinit[r] = sl2 * (float)(16 * (r >> 3) + 8 * hio + (r & 7)); }
    const int nsub_w = qb * 8 + wid + 1, NT = 4 * qb + 4;
    const bf16_t* Kbh = Kb + tokbase * 1024 + h * 128;
    const bf16_t* Vbh = VT + tokbase * 1024 + h * 128;
    unsigned kgo[2], vgo[2];
#pragma unroll
    for (int i = 0; i < 2; ++i) { const int kr = 4 * (2 * wid + i) + (lane >> 4), vr = 8 * (2 * wid + i) + (lane >> 3);
        kgo[i] = (unsigned)(kr * 1024 + (((lane & 15) ^ (kr & 15)) * 8)) * 2u;
        vgo[i] = (unsigned)(kr * 1024 + (((lane & 15) ^ (((kr & 3) << 2) | ((kr >> 2) & 3))) * 8)) * 2u; (void)vr; }
#define DMAT(kt, bf) do { const char* kb_ = (const char*)Kbh + (size_t)(unsigned)__builtin_amdgcn_readfirstlane((kt) * 131072); \
        const char* vb_ = (const char*)Vbh + (size_t)(unsigned)__builtin_amdgcn_readfirstlane((kt) * 131072); \
        _Pragma("unroll") for (int i_ = 0; i_ < 2; ++i_) { \
        __builtin_amdgcn_global_load_lds((const unsigned*)(kb_ + kgo[i_]), (LAS unsigned*)(lds + (bf) * KT_BYTES + (2 * wid + i_) * 1024), 16, 0, 0); \
        __builtin_amdgcn_global_load_lds((const unsigned*)(vb_ + vgo[i_]), (LAS unsigned*)(lds + LDS_VOFF + (bf) * VT_BYTES + (2 * wid + i_) * 1024), 16, 0, 0); } } while (0)
    const int krow = pi32(j32);
    const int kbase = krow * 256 + (((krow & 15) ^ hi) << 4);
    const int vbase = j32 * 128 + ((((j32 >> 1) & 7) ^ hi) << 4);
    const LAS unsigned char* kptr[2][4]; const LAS unsigned char* vptr[4][2];
#pragma unroll
    for (int c = 0; c < 2; ++c)
#pragma unroll
        for (int s_ = 0; s_ < 4; ++s_) kptr[c][s_] = lds + (kbase ^ ((c * 8 + s_ * 2) << 4));
    {
      const int q_ = (lane >> 2) & 3, p_ = lane & 3, g_ = (lane >> 4) & 1;
#pragma unroll
      for (int dt = 0; dt < 4; ++dt)
#pragma unroll
          for (int h4 = 0; h4 < 2; ++h4) { const int row_ = 8 * hi + 4 * h4 + q_, f_ = (q_ << 2) | ((2 * hi + h4) & 3), ch_ = dt * 4 + g_ * 2 + (p_ >> 1);
              vptr[dt][h4] = lds + LDS_VOFF + 256 * row_ + 16 * (ch_ ^ f_) + 8 * (p_ & 1); } }
#define WAIT_BAR(N) asm volatile("s_waitcnt vmcnt(" #N ") lgkmcnt(0)\n\ts_barrier" ::: "memory")
    asm volatile("s_waitcnt vmcnt(0)" ::: "memory");
    DMAT(NT - 1, 0); DMAT(NT - 2, 1);
#pragma unroll 1
    for (int it0 = 0; it0 < NT; it0 += NBUF) {
#pragma unroll
        for (int buf = 0; buf < NBUF; ++buf) {
            const int it = it0 + buf;
            if (it < NT) {
                const int kt = NT - 1 - it;
                if (it + 1 < NT) WAIT_BAR(4); else WAIT_BAR(0);
                if (it + 2 < NT) DMAT(kt - 2, (buf + 2) % NBUF);
#pragma unroll
                for (int st = 1; st >= 0; --st) {
                    const int sub = 2 * kt + st;
                    if (sub < nsub_w) {
                        const float cb = sl2 * (float)(sub * 32 - qpos);
                        attn_sub<true>(O, qlds, mrun, lrun, kptr, vptr, buf * KT_BYTES + st * 8192, buf * VT_BYTES + st * 8192, cinit, cb, j32, hi, sub == nsub_w - 1);
                    }
                }
            }
        }
    }
    asm volatile("s_waitcnt lgkmcnt(0)\n\ts_barrier" ::: "memory");
#undef WAIT_BAR
#undef DMAT
    const float inv0 = 1.f / hsum32(lrun[0]), k1 = -lam / hsum32(lrun[1]);
    float ss = 0.f;
#pragma unroll
    for (int dt = 0; dt < 4; ++dt)
#pragma unroll
        for (int r = 0; r < 16; ++r) { const float o = O[0][dt][r] * inv0 + O[1][dt][r] * k1; O[0][dt][r] = o; ss += o * o; }
    const float rs = rsqrtf(hsum32(ss) * (1.f / 128.f) + EPS) * (1.f - LAM_INIT);
    int hie = hi, qpe = qpos; asm volatile("" : "+v"(hie), "+v"(qpe));
    const size_t orow = (tokbase + qpe) * 1024 + h * 128;
#pragma unroll
    for (int dt = 0; dt < 4; ++dt)
#pragma unroll
        for (int rq = 0; rq < 4; ++rq) { const int dv = 32 * dt + 8 * rq + 4 * hie;
            const f32x4 gs = *(const f32x4*)(gsub + dv); const u32x2 zz = *(const u32x2*)(Zs + orow + dv);
            u32x2 w; w.x = pk2(O[0][dt][4 * rq] * rs * gs.x * bflo(zz.x), O[0][dt][4 * rq + 1] * rs * gs.y * bfhi(zz.x));
            w.y = pk2(O[0][dt][4 * rq + 2] * rs * gs.z * bflo(zz.y), O[0][dt][4 * rq + 3] * rs * gs.w * bfhi(zz.y));
            *(u32x2*)(og + orow + dv) = w; }
}

__device__ __forceinline__ void attn_phase(LAS unsigned char* lds, const bf16_t* Qb, const bf16_t* Kb, const bf16_t* VT, const bf16_t* Zs, bf16_t* og, const float* gsub, float lam) {
    for (int vb = blockIdx.x; vb < 256; vb += gridDim.x) {
        const int bh = vb & 127, half = vb >> 7;
#pragma unroll 1
        for (int ui = 0; ui < 4; ++ui) {
            const int qb = half == 0 ? (ui == 0 ? 7 : ui == 1 ? 0 : ui == 2 ? 5 : 2) : (ui == 0 ? 6 : ui == 1 ? 1 : ui == 2 ? 4 : 3);
            attn_unit(lds, bh >> 3, bh & 7, qb, Qb, Kb, VT, Zs, og, gsub, lam);
        }
    }
}

#ifndef REP_PH
#define REP_PH -1
#endif
#ifndef REP_N
#define REP_N 1
#endif
#define NREP(k) ((k) == REP_PH ? REP_N : 1)
#ifndef N_CG_SYNC
#define N_CG_SYNC 0
#endif
#ifndef MK_MULTI
#define MK_MULTI 0
#endif
__global__ void __launch_bounds__(NTHREADS, 2) yoco_fwd(Args a) {
    extern __shared__ __attribute__((aligned(16))) unsigned char lds_raw[];
    LAS unsigned char* lds = (LAS unsigned char*)lds_raw;
    cg::grid_group grid = cg::this_grid();
    const int tid = threadIdx.x, lane = tid & 63, wave = __builtin_amdgcn_readfirstlane(tid >> 6);
    const int lo = a.ph_lo, hi = a.ph_hi;
    const XcdBarrier xbar = xcd_barrier_init((unsigned*)(a.ws + WS_CTL), (volatile LAS unsigned*)lds);
    unsigned char* ws = a.ws;
    bf16_t* SA = (bf16_t*)(ws + WS_A); bf16_t* SB = (bf16_t*)(ws + WS_B); bf16_t* SC = (bf16_t*)(ws + WS_C); bf16_t* SF = (bf16_t*)(ws + WS_F); bf16_t* SG = (bf16_t*)(ws + WS_G); bf16_t* SH = (bf16_t*)(ws + WS_H);
#define IN(k) (lo <= (k) && (k) < hi)
#define SEAM(k) do { if (IN(k) && IN((k) + 1)) { if ((k) < N_CG_SYNC) grid.sync(); else xcd_barrier(xbar); } } while (0)
    if (lo > hi) grid.sync();
    if (IN(0)) { for (int rep = 0; rep < NREP(0); ++rep) p0_phase(a, lds, lane, wave); }
    SEAM(0);
    if (IN(1)) {
        pg8::Gemm g{SA, (const bf16_t*)(ws + WS_WT1), MTOK, 3072, 1024}; pg8::StaticOrder S; S.init(MTOK, 3072, gridDim.x, blockIdx.x); S.rep = NREP(1);
        pg8::EpiGlu E{SB, SC};
        pg8::gemm_phase<pg8::EpiGlu, pg8::StaticOrder, true, true>(lds, g, S, E);
    }
    SEAM(1);
    if (IN(2)) { for (int rep = 0; rep < NREP(2); ++rep) conv_phase(lds, SB, SC, SA, a.in[3], a.in[4], a.in[5], a.in[6]); }
    SEAM(2);
    if (IN(3)) {
        pg8::Gemm g{SA, (const bf16_t*)(ws + WS_WT2), MTOK, 1024, 1024}; pg8::StaticOrder S; S.init(MTOK, 1024, gridDim.x, blockIdx.x); S.rep = NREP(3);
        pg8::EpiPlain E{SB, 1024, 1.f};
        pg8::gemm_phase<pg8::EpiPlain, pg8::StaticOrder, true, true>(lds, g, S, E);
    }
    SEAM(3);
    if (IN(4)) { for (int rep = 0; rep < NREP(4); ++rep) resid_phase<true>(a.in[0], nullptr, SB, a.in[8], nullptr, (float*)(ws + WS_RS), SH, lane, wave); }
    SEAM(4);
    if (IN(5)) {
        {
            static_assert(WS_WT3V == WS_WT3 + (size_t)3072 * 1024 * 2 && WS_G - WS_F == WS_C - WS_B, "K|Q|Z|V weights contiguous, output slots equally spaced");
            pg8::Gemm g{SH, (const bf16_t*)(ws + WS_WT3), MTOK, 4096, 1024}; pg8::StaticOrder S; S.init(MTOK, 4096, gridDim.x, blockIdx.x); S.rep = NREP(5);
            pg8::EpiKQZ E{SB, (size_t)(WS_C - WS_B) / 2, 0.125f * LOG2E};   static_assert(WS_C - WS_B == WS_F - WS_C, "K|Q|Z slots equally spaced");
            pg8::gemm_phase<pg8::EpiKQZ, pg8::StaticOrder, true, true>(lds, g, S, E);
        }
    }
    SEAM(5);
    if (IN(6)) {
        const float* lp = a.in[13];
        const float sa = wave_sum(lp[lane] * lp[64 + lane]), sb = wave_sum(lp[128 + lane] * lp[192 + lane]);
        const float lam = expf(sa) - expf(sb) + LAM_INIT;
        for (int rep = 0; rep < NREP(6); ++rep) attn_phase(lds, SC, SB, SG, SF, SA, a.in[14], lam);
    }
    SEAM(6);
    if (IN(7)) {
        pg8::Gemm g{SA, (const bf16_t*)(ws + WS_WT4), MTOK, 1024, 1024}; pg8::StaticOrder S; S.init(MTOK, 1024, gridDim.x, blockIdx.x);
        pg8::EpiPlain E{SB, 1024, 1.f};
        pg8::gemm_phase<pg8::EpiPlain, pg8::StaticOrder, true, true>(lds, g, S, E);
    }
    SEAM(7);
    if (IN(8)) { resid_phase<false>(nullptr, SH, SB, a.in[16], a.out, (float*)(ws + WS_RS), nullptr, lane, wave); }
#undef IN
#undef SEAM
}

extern "C" void kernel_launch(void* const* d_in, const int* in_sizes, int n_in, void* d_out, int out_size, void* d_ws, size_t ws_size, hipStream_t stream) {
    static int grid = 0;
    if (grid == 0) {
        if (n_in != 17 || in_sizes[0] != MTOK * DM || out_size != MTOK * DM || ws_size < WS_END) {
            fprintf(stderr, "kernel_launch: unexpected shapes (n_in %d in0 %d out %d ws %zu)\n", n_in, n_in > 0 ? in_sizes[0] : -1, out_size, ws_size); grid = -1; return; }
        int dev = 0, cus = 0, per_cu = 0;
        hipGetDevice(&dev);
        hipDeviceGetAttribute(&cus, hipDeviceAttributeMultiprocessorCount, dev);
        if (hipFuncSetAttribute((const void*)yoco_fwd, hipFuncAttributeMaxDynamicSharedMemorySize, LDS_BYTES) != hipSuccess) fprintf(stderr, "kernel_launch: hipFuncSetAttribute failed\n");
        if (hipOccupancyMaxActiveBlocksPerMultiprocessor(&per_cu, (const void*)yoco_fwd, NTHREADS, LDS_BYTES) != hipSuccess || per_cu < 1) {
            fprintf(stderr, "kernel_launch: occupancy query says %d blocks/CU\n", per_cu); per_cu = 1; }
        (void)hipGetLastError();
        grid = cus * per_cu; if (grid > 256) grid = 256;
        fprintf(stderr, "kernel_launch: grid %d (cus %d, per_cu %d)\n", grid, cus, per_cu);
    }
    if (grid < 0) return;
    if (hipMemsetAsync((char*)d_ws + WS_CTL, 0, CTL_BYTES, stream) != hipSuccess) fprintf(stderr, "kernel_launch: memset of the barrier words failed\n");
    Args a{};
    for (int i = 0; i < 17; ++i) a.in[i] = (const float*)d_in[i];
    a.out = (float*)d_out; a.ws = (unsigned char*)d_ws;
#if MK_MULTI
    for (int p = 0; p < 9; ++p) { a.ph_lo = p; a.ph_hi = p + 1; hipLaunchKernelGGL(yoco_fwd, dim3(grid), dim3(NTHREADS), LDS_BYTES, stream, a); }
#else
    a.ph_lo = 0; a.ph_hi = 9;
    void* args[] = {&a};
    hipError_t e = hipLaunchCooperativeKernel((const void*)yoco_fwd, dim3(grid), dim3(NTHREADS), args, LDS_BYTES, stream);
    if (e != hipSuccess) fprintf(stderr, "cooperative launch failed: %s (grid %d)\n", hipGetErrorString(e), grid);
#endif
}
```

```cpp
#include <hip/hip_runtime.h>
#include <hip/hip_cooperative_groups.h>
#include <cstdio>
#include <cstdint>
namespace cg = cooperative_groups;
namespace pg8 {
#define PG8_LAS __attribute__((address_space(3)))
typedef unsigned short bf16_t;
typedef short bf16x8 __attribute__((ext_vector_type(8)));
typedef float f32x4 __attribute__((ext_vector_type(4)));
typedef unsigned u32x4 __attribute__((ext_vector_type(4)));
constexpr int BM = 256, BK = 64, HALF = 128, HTB = HALF * BK * 2  , STAGE_BYTES = 8 * HTB, NXCD = 8, WGM = 8;

__host__ __device__ __forceinline__ int lds_byte(int r, int c) { const int st = (r >> 4) * 2 + (c >> 5), rr = r & 15, cc = c & 31, ob = rr * 64 + cc * 2; return st * 1024 + (ob ^ (((ob >> 9) & 1) << 5)); }
__host__ __device__ __forceinline__ void stage_rc(int b, int& R, int& C) { const int st = b / 1024, sb = b % 1024, swz = sb ^ (((sb >> 9) & 1) << 5); R = (st >> 1) * 16 + swz / 64; C = (st & 1) * 32 + (swz % 64) / 2; }
__host__ __device__ __forceinline__ int perm32(int rho) { const int n = rho >> 4, i = rho & 15; return 8 * (i >> 2) + 4 * n + (i & 3); }

struct Unit { int pm, pn; };
struct Gemm { const bf16_t* A; const bf16_t* Bt; int M, N, K; };

struct StaticOrder {
    int nM, nN, nwg, G, c, rep = 1;
    __host__ __device__ void init(int M, int N, int G_, int c_) { nM = M / BM; nN = N / BM; nwg = nM * nN; G = G_; c = c_; }
    __host__ __device__ bool next(int i, Unit& u) const {
        long L = (long)i * G + c; if (L >= (long)nwg * rep) return false;
        if (L >= nwg) L -= nwg;
        int wgid = (int)L; { const int q = nwg / NXCD, r = nwg % NXCD, xcd = wgid % NXCD, off = wgid / NXCD; wgid = (xcd < r ? xcd * (q + 1) : r * (q + 1) + (xcd - r) * q) + off; }
        const int nig = WGM * nN, gid = wgid / nig, fm = gid * WGM, gsz = (nM - fm) < WGM ? (nM - fm) : WGM;
        u.pm = fm + ((wgid % nig) % gsz); u.pn = (wgid % nig) / gsz; return true;
    }
    __device__ __forceinline__ void a_ready(const Unit&) const {}
    __device__ __forceinline__ void done(const Unit&) const {}
};

typedef float f32x2 __attribute__((ext_vector_type(2)));
typedef __bf16 bf16x2c __attribute__((ext_vector_type(2)));
__device__ __forceinline__ unsigned cvt_pk_bf16(float lo, float hi) { const f32x2 v = {lo, hi}; const bf16x2c b = __builtin_convertvector(v, bf16x2c); return __builtin_bit_cast(unsigned, b); }
template <class Epi, class Sched, bool ALIGN_EPI = false, bool SP2 = false>
__device__ __forceinline__ void gemm_phase(PG8_LAS unsigned char* lds, const Gemm g, const Sched& S, const Epi& E) {
    const int tid = threadIdx.x, wid = __builtin_amdgcn_readfirstlane(tid >> 6), lane = tid & 63, wr = wid >> 2, wc = wid & 3, fr = lane & 15, fq = lane >> 4;
    const int K = g.K, nt = K / BK;
    unsigned voffA[2], voffB[2];
#pragma unroll
    for (int i = 0; i < 2; ++i) { int R, C; stage_rc(tid * 16 + i * 8192, R, C); const int Rb = Epi::PERM ? ((R & ~31) + perm32(R & 31)) : R;
        voffA[i] = (unsigned)(R * K + C) * 2u; voffB[i] = (unsigned)(Rb * K + C) * 2u; }
    const size_t kstep = (size_t)(BK * 2);
    const size_t hstep = (size_t)HALF * K * 2;
    const size_t tstep = 2 * hstep;
    const unsigned ldsw = (unsigned)wid * 1024u;
    const int aoff = lds_byte(wr * 64 + fr, fq * 8), boff = lds_byte(wc * 32 + fr, fq * 8);
#define PG8_SA(b, h) (((b) * 2 + (h)) * HTB)
#define PG8_SB(b, h) ((4 + (b) * 2 + (h)) * HTB)
#define PG8_STAGE(bufoff, gbase, voff) do { _Pragma("unroll") for (int _i = 0; _i < 2; ++_i) \
        __builtin_amdgcn_global_load_lds((const unsigned*)((const char*)(gbase) + (voff)[_i]), (PG8_LAS unsigned*)(lds + (bufoff) + ldsw + _i * 8192), 16, 0, 0); } while (0)
#define PG8_LDA(dst, b, h) do { _Pragma("unroll") for (int m = 0; m < 4; ++m) _Pragma("unroll") for (int k = 0; k < 2; ++k) dst[m][k] = *(const PG8_LAS bf16x8*)(lds + PG8_SA(b, h) + aoff + m * 2048 + k * 1024); } while (0)
#define PG8_LDB(dst, b, h) do { _Pragma("unroll") for (int n = 0; n < 2; ++n) _Pragma("unroll") for (int k = 0; k < 2; ++k) dst[n][k] = *(const PG8_LAS bf16x8*)(lds + PG8_SB(b, h) + boff + n * 2048 + k * 1024); } while (0)
#define PG8_MMA(ai, bj, At, Bt) do { __builtin_amdgcn_s_setprio(1); _Pragma("unroll") for (int m = 0; m < 4; ++m) _Pragma("unroll") for (int n = 0; n < 2; ++n) _Pragma("unroll") for (int k = 0; k < 2; ++k) \
        acc[ai][bj][m][n] = __builtin_amdgcn_mfma_f32_16x16x32_bf16(Bt[n][k], At[m][k], acc[ai][bj][m][n], 0, 0, 0); __builtin_amdgcn_s_setprio(0); } while (0)
#define PG8_WAIT_V(n) asm volatile("s_waitcnt vmcnt(" #n ")" ::: "memory")
#define PG8_WAIT_L(n) asm volatile("s_waitcnt lgkmcnt(" #n ")" ::: "memory")
#define PG8_BAR __builtin_amdgcn_s_barrier()
#define PG8_SCHED __builtin_amdgcn_sched_barrier(0)
    Unit cur, nxt; int ui = 0;
    if (!S.next(0, cur)) return;
    f32x4 acc[2][2][4][2];
#pragma unroll
    for (int a = 0; a < 2; ++a)
#pragma unroll
        for (int b = 0; b < 2; ++b)
#pragma unroll
            for (int m = 0; m < 4; ++m)
#pragma unroll
                for (int n = 0; n < 2; ++n) acc[a][b][m][n] = (f32x4){0.f, 0.f, 0.f, 0.f};
    bf16x8 At[4][2], B0[2][2], B1[2][2];
    const char* cA = (const char*)g.A + (size_t)cur.pm * tstep; const char* cB = (const char*)g.Bt + (size_t)cur.pn * tstep;
    S.a_ready(cur);
    if constexpr (SP2) {
        PG8_STAGE(PG8_SB(0, 0), cB, voffB); PG8_STAGE(PG8_SB(0, 1), cB + hstep, voffB); PG8_STAGE(PG8_SA(0, 0), cA, voffA); PG8_STAGE(PG8_SA(0, 1), cA + hstep, voffA);
        if (wr == 1) PG8_BAR;
        PG8_WAIT_V(2); PG8_BAR;
        PG8_STAGE(PG8_SB(1, 0), cB + kstep, voffB); PG8_STAGE(PG8_SA(1, 0), cA + kstep, voffA); PG8_STAGE(PG8_SB(1, 1), cB + hstep + kstep, voffB);
        PG8_WAIT_V(6); PG8_BAR;
    } else {
        PG8_STAGE(PG8_SB(0, 0), cB, voffB); PG8_STAGE(PG8_SA(0, 0), cA, voffA); PG8_STAGE(PG8_SB(0, 1), cB + hstep, voffB); PG8_STAGE(PG8_SA(0, 1), cA + hstep, voffA);
        if (wr == 1) PG8_BAR;
        PG8_WAIT_V(4); PG8_BAR;
        PG8_STAGE(PG8_SB(1, 0), cB + kstep, voffB); PG8_STAGE(PG8_SA(1, 0), cA + kstep, voffA); PG8_STAGE(PG8_SB(1, 1), cB + hstep + kstep, voffB);
        PG8_WAIT_V(6); PG8_BAR;
    }
    for (;;) {
        const bool has_next = S.next(ui + 1, nxt);
        const char* nA = has_next ? (const char*)g.A + (size_t)nxt.pm * tstep : cA; const char* nB = has_next ? (const char*)g.Bt + (size_t)nxt.pn * tstep : cB;
        for (int t = 0; t < nt; t += 2) {
            const bool last = (t == nt - 2);
            const char* a1 = cA + (size_t)(t + 1) * kstep;
            const char* a2 = last ? nA : cA + (size_t)(t + 2) * kstep; const char* b2 = last ? nB : cB + (size_t)(t + 2) * kstep;
            const char* a3 = a2 + kstep; const char* b3 = b2 + kstep;
            if (last && has_next) S.a_ready(nxt);
            if constexpr (SP2) {
            PG8_LDB(B0, 0, 0); PG8_LDB(B1, 0, 1); PG8_SCHED; PG8_LDA(At, 0, 0); PG8_STAGE(PG8_SA(1, 1), a1 + hstep, voffA);
            PG8_WAIT_V(8); PG8_WAIT_L(0); PG8_BAR; PG8_MMA(0, 0, At, B0); PG8_MMA(0, 1, At, B1); PG8_BAR; PG8_SCHED;
            PG8_LDA(At, 0, 1); PG8_STAGE(PG8_SB(0, 0), b2, voffB); PG8_STAGE(PG8_SB(0, 1), b2 + hstep, voffB); PG8_STAGE(PG8_SA(0, 0), a2, voffA);
            PG8_WAIT_V(8); PG8_WAIT_L(0); PG8_BAR; PG8_MMA(1, 0, At, B0); PG8_MMA(1, 1, At, B1); PG8_BAR; PG8_SCHED;
            PG8_LDB(B0, 1, 0); PG8_LDB(B1, 1, 1); PG8_SCHED; PG8_LDA(At, 1, 0); PG8_STAGE(PG8_SA(0, 1), a2 + hstep, voffA);
            PG8_WAIT_V(8); PG8_WAIT_L(0); PG8_BAR; PG8_MMA(0, 0, At, B0); PG8_MMA(0, 1, At, B1); PG8_BAR; PG8_SCHED;
            PG8_LDA(At, 1, 1); PG8_STAGE(PG8_SB(1, 0), b3, voffB); PG8_STAGE(PG8_SB(1, 1), b3 + hstep, voffB); PG8_STAGE(PG8_SA(1, 0), a3, voffA);
            PG8_WAIT_V(8); PG8_WAIT_L(0); PG8_BAR; PG8_MMA(1, 0, At, B0); PG8_MMA(1, 1, At, B1); PG8_BAR; PG8_SCHED;
            } else {
            PG8_LDB(B0, 0, 0); PG8_SCHED; PG8_LDA(At, 0, 0); PG8_STAGE(PG8_SA(1, 1), a1 + hstep, voffA);
            PG8_WAIT_L(8); PG8_BAR; PG8_WAIT_L(0); PG8_MMA(0, 0, At, B0); PG8_BAR; PG8_SCHED;
            PG8_LDB(B1, 0, 1); PG8_STAGE(PG8_SB(0, 0), b2, voffB);
            PG8_BAR; PG8_WAIT_L(0); PG8_MMA(0, 1, At, B1); PG8_BAR;
            PG8_LDA(At, 0, 1); PG8_STAGE(PG8_SA(0, 0), a2, voffA);
            PG8_BAR; PG8_WAIT_L(0); PG8_MMA(1, 0, At, B0); PG8_BAR; PG8_SCHED;
            PG8_STAGE(PG8_SB(0, 1), b2 + hstep, voffB);
            PG8_WAIT_V(6); PG8_BAR; PG8_MMA(1, 1, At, B1); PG8_BAR;
            PG8_LDB(B0, 1, 0); PG8_SCHED; PG8_LDA(At, 1, 0); PG8_STAGE(PG8_SA(0, 1), a2 + hstep, voffA);
            PG8_WAIT_L(8); PG8_BAR; PG8_WAIT_L(0); PG8_MMA(0, 0, At, B0); PG8_BAR; PG8_SCHED;
            PG8_LDB(B1, 1, 1); PG8_STAGE(PG8_SB(1, 0), b3, voffB);
            PG8_BAR; PG8_WAIT_L(0); PG8_MMA(0, 1, At, B1); PG8_BAR;
            PG8_LDA(At, 1, 1); PG8_STAGE(PG8_SA(1, 0), a3, voffA);
            PG8_BAR; PG8_WAIT_L(0); PG8_MMA(1, 0, At, B0); PG8_BAR; PG8_SCHED;
            PG8_STAGE(PG8_SB(1, 1), b3 + hstep, voffB);
            PG8_WAIT_V(6); PG8_BAR; PG8_MMA(1, 1, At, B1); PG8_BAR;
            }
        }
        if constexpr (ALIGN_EPI) { if (wr == 0) PG8_BAR; }
        if constexpr (!Epi::AFTER_DRAIN) { E(acc, cur, wr, wc, fr, fq); S.done(cur); }
        if (!has_next) break;
#pragma unroll
        for (int a = 0; a < 2; ++a)
#pragma unroll
            for (int b = 0; b < 2; ++b)
#pragma unroll
                for (int m = 0; m < 4; ++m)
#pragma unroll
                    for (int n = 0; n < 2; ++n) acc[a][b][m][n] = (f32x4){0.f, 0.f, 0.f, 0.f};
        cur = nxt; cA = nA; cB = nB; ++ui;
        if constexpr (ALIGN_EPI) { if (wr == 1) PG8_BAR; }
    }
    PG8_WAIT_V(0);
    if constexpr (!ALIGN_EPI) { if (wr == 0) PG8_BAR; }
    PG8_BAR;
    if constexpr (Epi::AFTER_DRAIN) { E.fused(acc, cur, wr, wc, fr, fq, lds, wid, lane); S.done(cur); }
#undef PG8_SA
#undef PG8_SB
#undef PG8_STAGE
#undef PG8_LDA
#undef PG8_LDB
#undef PG8_MMA
#undef PG8_WAIT_V
#undef PG8_WAIT_L
#undef PG8_BAR
#undef PG8_SCHED
}
}

namespace pg8 {
__device__ __forceinline__ float sigm(float v) { return __builtin_amdgcn_rcpf(1.f + __builtin_amdgcn_exp2f(-1.4426950408889634f * v)); }
struct EpiPlain {
    static constexpr bool PERM = true, AFTER_DRAIN = false;
    bf16_t* O; int ldc; float scale;
    __device__ __forceinline__ void operator()(const f32x4 (&acc)[2][2][4][2], const Unit& u, int wr, int wc, int fr, int fq) const {
        const int row0 = u.pm * BM + wr * 64 + fr, col0 = u.pn * BM + wc * 32 + 8 * fq;
#pragma unroll
        for (int ai = 0; ai < 2; ++ai)
#pragma unroll
            for (int m = 0; m < 4; ++m) { bf16_t* rowp = O + (size_t)(row0 + ai * HALF + m * 16) * ldc + col0;
#pragma unroll
                for (int bj = 0; bj < 2; ++bj) { const f32x4 v0 = acc[ai][bj][m][0] * scale, v1 = acc[ai][bj][m][1] * scale;
                    u32x4 w; w.x = cvt_pk_bf16(v0[0], v0[1]); w.y = cvt_pk_bf16(v0[2], v0[3]); w.z = cvt_pk_bf16(v1[0], v1[1]); w.w = cvt_pk_bf16(v1[2], v1[3]);
                    *(u32x4*)(rowp + bj * HALF) = w; } }
    }
};
struct EpiGlu {
    static constexpr bool PERM = true, AFTER_DRAIN = false;
    bf16_t* G; bf16_t* SZ;
    __device__ __forceinline__ void operator()(const f32x4 (&acc)[2][2][4][2], const Unit& u, int wr, int wc, int fr, int fq) const {
        const int row0 = u.pm * BM + wr * 64 + fr;
        if (u.pn < 8) {
            const int col0 = u.pn * HALF + wc * 32 + 8 * fq;
#pragma unroll
            for (int ai = 0; ai < 2; ++ai)
#pragma unroll
                for (int m = 0; m < 4; ++m) { bf16_t* rowp = G + (size_t)(row0 + ai * HALF + m * 16) * 1024 + col0;
                    f32x4 v0, v1;
#pragma unroll
                    for (int j = 0; j < 4; ++j) { v0[j] = acc[ai][0][m][0][j] * sigm(acc[ai][1][m][0][j]); v1[j] = acc[ai][0][m][1][j] * sigm(acc[ai][1][m][1][j]); }
                    u32x4 w; w.x = cvt_pk_bf16(v0[0], v0[1]); w.y = cvt_pk_bf16(v0[2], v0[3]); w.z = cvt_pk_bf16(v1[0], v1[1]); w.w = cvt_pk_bf16(v1[2], v1[3]);
                    *(u32x4*)rowp = w; }
        } else {
            const int col0 = (u.pn - 8) * BM + wc * 32 + 8 * fq;
#pragma unroll
            for (int ai = 0; ai < 2; ++ai)
#pragma unroll
                for (int m = 0; m < 4; ++m) { bf16_t* rowp = SZ + (size_t)(row0 + ai * HALF + m * 16) * 1024 + col0;
#pragma unroll
                    for (int bj = 0; bj < 2; ++bj) { f32x4 v0 = acc[ai][bj][m][0], v1 = acc[ai][bj][m][1];
#pragma unroll
                        for (int j = 0; j < 4; ++j) { v0[j] = v0[j] * sigm(v0[j]); v1[j] = v1[j] * sigm(v1[j]); }
                        u32x4 w; w.x = cvt_pk_bf16(v0[0], v0[1]); w.y = cvt_pk_bf16(v0[2], v0[3]); w.z = cvt_pk_bf16(v1[0], v1[1]); w.w = cvt_pk_bf16(v1[2], v1[3]);
                        *(u32x4*)(rowp + bj * HALF) = w; } }
        }
    }
};
struct EpiKQZ {
    static constexpr bool PERM = true, AFTER_DRAIN = false;
    bf16_t* Kb; size_t seg_stride; float qscale;
    __device__ __forceinline__ void operator()(const f32x4 (&acc)[2][2][4][2], const Unit& u, int wr, int wc, int fr, int fq) const {
        const int row0 = u.pm * BM + wr * 64 + fr; const int seg = u.pn >> 2;
        bf16_t* base = Kb + (size_t)seg * seg_stride;
        const float sc = seg == 1 ? qscale : 1.f;
        const int col0 = (u.pn & 3) * BM + wc * 32 + 8 * fq;
#pragma unroll
        for (int ai = 0; ai < 2; ++ai)
#pragma unroll
            for (int m = 0; m < 4; ++m) { bf16_t* rowp = base + (size_t)(row0 + ai * HALF + m * 16) * 1024 + col0;
#pragma unroll
                for (int bj = 0; bj < 2; ++bj) { f32x4 v0 = acc[ai][bj][m][0] * sc, v1 = acc[ai][bj][m][1] * sc;
                    if (seg == 2) {
#pragma unroll
                        for (int j = 0; j < 4; ++j) { v0[j] = v0[j] * sigm(v0[j]); v1[j] = v1[j] * sigm(v1[j]); } }
                    u32x4 w; w.x = cvt_pk_bf16(v0[0], v0[1]); w.y = cvt_pk_bf16(v0[2], v0[3]); w.z = cvt_pk_bf16(v1[0], v1[1]); w.w = cvt_pk_bf16(v1[2], v1[3]);
                    *(u32x4*)(rowp + bj * HALF) = w; } }
    }
};
}

#define LAS __attribute__((address_space(3)))
typedef pg8::bf16_t bf16_t;
typedef pg8::bf16x8 bf16x8;
typedef pg8::f32x4 f32x4;
typedef pg8::u32x4 u32x4;
typedef float f32x16 __attribute__((ext_vector_type(16)));
typedef float f32x2v __attribute__((ext_vector_type(2)));
typedef unsigned u32x2 __attribute__((ext_vector_type(2)));

constexpr int BATCH = 16, SEQ = 2048, DM = 1024, MTOK = BATCH * SEQ;
constexpr int NH = 8, CK = 31;
constexpr float EPS = 1e-6f;
constexpr float LOG2E = 1.4426950408889634f;
constexpr float LAM_INIT = 0.4707130183435842f;
constexpr int NTHREADS = 512, NWAVES = 8;
constexpr int NRF0 = 8;
constexpr int NRF = 4;
constexpr int LDS_BYTES = 163840;
constexpr size_t MiB = 1u << 20;
constexpr size_t WS_WT1 = 0, WS_WT2 = 6 * MiB, WS_WT3 = 8 * MiB, WS_WT3V = 14 * MiB, WS_WT4 = 16 * MiB;
constexpr size_t WS_RS0 = 22 * MiB;
constexpr size_t WS_RS = 21 * MiB;
constexpr size_t WS_CTL = 20 * MiB, CTL_BYTES = 16384;
constexpr size_t WS_A = 32 * MiB, WS_B = 96 * MiB, WS_C = 160 * MiB, WS_F = 224 * MiB, WS_G = 288 * MiB, WS_H = 352 * MiB, WS_END = 416 * MiB;

struct Args { const float* in[17]; float* out; unsigned char* ws; int ph_lo, ph_hi; };

__device__ __forceinline__ float wave_sum(float v) {
#pragma unroll
    for (int o = 1; o < 64; o <<= 1) v += __shfl_xor(v, o);
    return v;
}
typedef __bf16 bf16x2_t __attribute__((ext_vector_type(2)));
__device__ __forceinline__ unsigned pk2(float lo, float hi) { const f32x2v v = {lo, hi}; const bf16x2_t b = __builtin_convertvector(v, bf16x2_t); return __builtin_bit_cast(unsigned, b); }
__device__ __forceinline__ float bflo(unsigned u) { return __builtin_bit_cast(float, u << 16); }
__device__ __forceinline__ float bfhi(unsigned u) { return __builtin_bit_cast(float, u & 0xffff0000u); }
#define LDS_WAIT() asm volatile("s_waitcnt lgkmcnt(0)" ::: "memory")

__device__ __forceinline__ void transpose_item(const float* W, int ldw, int col0, const float* gain, bf16_t* WT, int dst_row0, LAS float* scr, int kb, int lane) {
    const int k0 = 64 * kb;
    float wv[32];
#pragma unroll
    for (int i = 0; i < 32; ++i) { const int kk = 2 * i + (lane >> 5); wv[i] = W[(size_t)(k0 + kk) * ldw + col0 + (lane & 31)]; }
#pragma unroll
    for (int i = 0; i < 32; ++i) { const int kk = 2 * i + (lane >> 5); const float gg = gain ? gain[k0 + kk] : 1.f; scr[kk * 33 + (lane & 31)] = wv[i] * gg; }
    LDS_WAIT();
    const int c = lane & 7;
#pragma unroll
    for (int j = 0; j < 4; ++j) { const int n = (lane >> 3) + 8 * j; const LAS float* s = scr + (8 * c) * 33 + n;
        u32x4 o; o.x = pk2(s[0 * 33], s[1 * 33]); o.y = pk2(s[2 * 33], s[3 * 33]); o.z = pk2(s[4 * 33], s[5 * 33]); o.w = pk2(s[6 * 33], s[7 * 33]);
        *(u32x4*)(WT + (size_t)(dst_row0 + n) * 1024 + k0 + 8 * c) = o; }
    LDS_WAIT();
}

__device__ __forceinline__ void rms_row_to_bf16(const float* xrow, bf16_t* orow, int lane) {
    const f32x4* xr = (const f32x4*)xrow + lane;
    f32x4 v[4]; float s = 0.f;
#pragma unroll
    for (int j = 0; j < 4; ++j) { v[j] = xr[64 * j]; s += (v[j].x * v[j].x + v[j].y * v[j].y) + (v[j].z * v[j].z + v[j].w * v[j].w); }
    const float r = rsqrtf(wave_sum(s) * (1.f / DM) + EPS);
    u32x2* o8 = (u32x2*)orow + lane;
#pragma unroll
    for (int j = 0; j < 4; ++j) { u32x2 w; w.x = pk2(v[j].x * r, v[j].y * r); w.y = pk2(v[j].z * r, v[j].w * r); o8[64 * j] = w; }
}

__device__ __forceinline__ void p0_phase(const Args& a, LAS unsigned char* lds, int lane, int wave) {
    LAS float* scr = (LAS float*)(lds + wave * 16384);
    constexpr int NWT = 2, NWR = NWAVES - NWT;
    unsigned char* ws = a.ws;
    const bool is_tw = wave >= NWR;
    const int gw = is_tw ? blockIdx.x * NWT + (wave - NWR) : blockIdx.x * NWR + wave, NGW = is_tw ? gridDim.x * NWT : gridDim.x * NWR;
    if (is_tw)
    for (int it = gw; it < 9 * 512; it += NGW) {
        const int piece = it >> 9, r = it & 511, kb = r >> 5, cb = (r & 31) * 32;
        switch (piece) {
        case 0: transpose_item(a.in[2], 3072, cb, a.in[1], (bf16_t*)(ws + WS_WT1), (cb >> 7) * 256 + (cb & 127), scr, kb, lane); break;
        case 1: transpose_item(a.in[2], 3072, 1024 + cb, a.in[1], (bf16_t*)(ws + WS_WT1), (cb >> 7) * 256 + 128 + (cb & 127), scr, kb, lane); break;
        case 2: transpose_item(a.in[2], 3072, 2048 + cb, a.in[1], (bf16_t*)(ws + WS_WT1), 2048 + cb, scr, kb, lane); break;
        case 3: transpose_item(a.in[7], 1024, cb, nullptr, (bf16_t*)(ws + WS_WT2), cb, scr, kb, lane); break;
        case 4: transpose_item(a.in[10], 2048, cb, a.in[9], (bf16_t*)(ws + WS_WT3), cb, scr, kb, lane); break;
        case 5: transpose_item(a.in[10], 2048, 1024 + cb, a.in[9], (bf16_t*)(ws + WS_WT3V), cb, scr, kb, lane); break;
        case 6: transpose_item(a.in[12], 2048, cb, a.in[11], (bf16_t*)(ws + WS_WT3), 1024 + cb, scr, kb, lane); break;
        case 7: transpose_item(a.in[12], 2048, 1024 + cb, a.in[11], (bf16_t*)(ws + WS_WT3), 2048 + cb, scr, kb, lane); break;
        default: transpose_item(a.in[15], 1024, cb, nullptr, (bf16_t*)(ws + WS_WT4), cb, scr, kb, lane); break;
        }
    }
    bf16_t* xn0 = (bf16_t*)(ws + WS_A);
    if (!is_tw)
    for (int m0 = gw; m0 < MTOK; m0 += NRF0 * NGW) {
        f32x4 v[NRF0][4];
#pragma unroll
        for (int rr = 0; rr < NRF0; ++rr) { const int m = m0 + rr * NGW; if (m < MTOK) { const f32x4* xr = (const f32x4*)(a.in[0] + (size_t)m * DM) + lane;
#pragma unroll
            for (int j = 0; j < 4; ++j) v[rr][j] = __builtin_nontemporal_load(xr + 64 * j); } }
#pragma unroll
        for (int rr = 0; rr < NRF0; ++rr) { const int m = m0 + rr * NGW; if (m < MTOK) { float sq = 0.f;
#pragma unroll
            for (int j = 0; j < 4; ++j) sq += (v[rr][j].x * v[rr][j].x + v[rr][j].y * v[rr][j].y) + (v[rr][j].z * v[rr][j].z + v[rr][j].w * v[rr][j].w);
            const float r = rsqrtf(wave_sum(sq) * (1.f / DM) + EPS);
            if (lane == 0) ((float*)(ws + WS_RS0))[m] = 1.f / r;
            u32x2* o8 = (u32x2*)(xn0 + (size_t)m * DM) + lane;
#pragma unroll
            for (int j = 0; j < 4; ++j) { u32x2 w; w.x = pk2(v[rr][j].x * r, v[rr][j].y * r); w.y = pk2(v[rr][j].z * r, v[rr][j].w * r); o8[64 * j] = w; } } }
    }
}

#define RS_STEP(N, MASK) { const bool up_ = (lane & (MASK)) != 0; _Pragma("unroll") for (int i_ = 0; i_ < (N) / 2; ++i_) { \
        const float keep_ = up_ ? rv[i_ + (N) / 2] : rv[i_], send_ = up_ ? rv[i_] : rv[i_ + (N) / 2]; rv[i_] = keep_ + __shfl_xor(send_, (MASK)); } }
__device__ __forceinline__ void conv_phase(LAS unsigned char* lds, const bf16_t* g, const bf16_t* sz, bf16_t* cgo,
                                           const float* wdw, const float* bdw, const float* lng, const float* lnb) {
    const int tid = threadIdx.x, lane = tid & 63, wave = tid >> 6;
    LAS float* red = (LAS float*)(lds + 131072);
    LAS float* stat = red + 128;
    f32x2v w[CK];
#pragma unroll
    for (int k = 0; k < CK; ++k) w[k] = *(const f32x2v*)(wdw + k * 1024 + 2 * tid);
    const f32x2v bb = *(const f32x2v*)(bdw + 2 * tid), lg = *(const f32x2v*)(lng + 2 * tid), lb = *(const f32x2v*)(lnb + 2 * tid);
    for (int chunk = blockIdx.x; chunk < MTOK / 128; chunk += gridDim.x) {
        const int c0 = chunk * 128, s0 = c0 & (SEQ - 1);
        __syncthreads();
        for (int id = tid; id < 62 * 128; id += NTHREADS) { const int row = id >> 7, ch = id & 127;
            u32x4 v = {0u, 0u, 0u, 0u};
            if (s0 - 30 + row >= 0) v = *(const u32x4*)(g + (size_t)(c0 - 30 + row) * 1024 + ch * 8);
            *(LAS u32x4*)(lds + row * 2048 + ch * 16) = v; }
        __syncthreads();
#pragma unroll 1
        for (int tile = 0; tile < 4; ++tile) {
            u32x4 pf[8];
            if (tile < 3) {
#pragma unroll
                for (int i = 0; i < 8; ++i) { const int id = tid + NTHREADS * i; pf[i] = __builtin_nontemporal_load((const u32x4*)(g + (size_t)(c0 + 32 + 32 * tile + (id >> 7)) * 1024 + (id & 127) * 8)); } }
#pragma unroll 1
            for (int gq = 0; gq < 4; ++gq) {
                const int rbase = (32 * tile + 8 * gq) & 63;
                f32x2v v[38];
#pragma unroll
                for (int i = 0; i < 38; ++i) { const int slot = (rbase + i) & 63; const unsigned u = *(const LAS unsigned*)(lds + slot * 2048 + tid * 4); v[i] = (f32x2v){bflo(u), bfhi(u)}; }
                unsigned zz[8];
#pragma unroll
                for (int tt = 0; tt < 8; ++tt) zz[tt] = *(const unsigned*)(sz + (size_t)(c0 + 32 * tile + gq * 8 + tt) * 1024 + 2 * tid);
                f32x2v cv[8];
#pragma unroll
                for (int tt = 0; tt < 8; ++tt) { f32x2v acc = bb;
#pragma unroll
                    for (int k = 0; k < CK; ++k) acc = __builtin_elementwise_fma(w[k], v[tt + k], acc);
                    cv[tt] = acc; }
                float rv[16];
#pragma unroll
                for (int tt = 0; tt < 8; ++tt) { rv[2 * tt] = cv[tt].x + cv[tt].y; rv[2 * tt + 1] = cv[tt].x * cv[tt].x + cv[tt].y * cv[tt].y; }
                RS_STEP(16, 32) RS_STEP(8, 16) RS_STEP(4, 8) RS_STEP(2, 4)
                rv[0] += __shfl_xor(rv[0], 2); rv[0] += __shfl_xor(rv[0], 1);
                if ((lane & 3) == 0) red[wave * 16 + (lane >> 2)] = rv[0];
                __syncthreads();
                if (tid < 8) { float s = 0.f, q = 0.f;
#pragma unroll
                    for (int ww = 0; ww < 8; ++ww) { s += red[ww * 16 + 2 * tid]; q += red[ww * 16 + 2 * tid + 1]; }
                    const float mu = s * (1.f / 1024.f), var = fmaxf(q * (1.f / 1024.f) - mu * mu, 0.f);
                    stat[2 * tid] = mu; stat[2 * tid + 1] = rsqrtf(var + EPS); }
                __syncthreads();
#pragma unroll
                for (int tt = 0; tt < 8; ++tt) { const float mu = stat[2 * tt], rs = stat[2 * tt + 1];
                    float n0 = (cv[tt].x - mu) * rs * lg.x + lb.x, n1 = (cv[tt].y - mu) * rs * lg.y + lb.y;
                    n0 = n0 * pg8::sigm(n0) * bflo(zz[tt]); n1 = n1 * pg8::sigm(n1) * bfhi(zz[tt]);
                    *(unsigned*)(cgo + (size_t)(c0 + 32 * tile + gq * 8 + tt) * 1024 + 2 * tid) = pk2(n0, n1); }
            }
            if (tile < 3) {
#pragma unroll
                for (int i = 0; i < 8; ++i) { const int id = tid + NTHREADS * i; const int slot = (62 + 32 * tile + (id >> 7)) & 63;
                    *(LAS u32x4*)(lds + slot * 2048 + (id & 127) * 16) = pf[i]; }
                __syncthreads();
            }
        }
    }
}

template <bool FIRST>
__device__ __forceinline__ void resid_phase(const bf16_t* xinb, const float* rs_in, const bf16_t* y, const float* gpost, float* xout, float* rs_out, bf16_t* xn, int lane, int wave) {
    const int gw = blockIdx.x * NWAVES + wave, NGW = gridDim.x * NWAVES;
    f32x4 gp[4];
#pragma unroll
    for (int j = 0; j < 4; ++j) gp[j] = ((const f32x4*)gpost)[lane + 64 * j];
    for (int m0 = gw; m0 < MTOK; m0 += NRF * NGW) {
        f32x4 xv[NRF][4], yv[NRF][4]; float s[NRF];
#pragma unroll
        for (int rr = 0; rr < NRF; ++rr) s[rr] = 0.f;
#pragma unroll
        for (int rr = 0; rr < NRF; ++rr) { const int m = m0 + rr * NGW; if (m < MTOK) {
            const u32x2* yr = (const u32x2*)(y + (size_t)m * DM) + lane;
            { const u32x2* xr = (const u32x2*)(xinb + (size_t)m * DM) + lane; const float rsc = rs_in[m];
#pragma unroll
                for (int j = 0; j < 4; ++j) { const u32x2 u = __builtin_nontemporal_load(xr + 64 * j); xv[rr][j] = (f32x4){bflo(u.x), bfhi(u.x), bflo(u.y), bfhi(u.y)} * rsc; } }
#pragma unroll
            for (int j = 0; j < 4; ++j) { const u32x2 u = __builtin_nontemporal_load(yr + 64 * j); yv[rr][j] = (f32x4){bflo(u.x), bfhi(u.x), bflo(u.y), bfhi(u.y)}; } } }
#pragma unroll
        for (int rr = 0; rr < NRF; ++rr) { const int m = m0 + rr * NGW; if (m < MTOK) {
#pragma unroll
            for (int j = 0; j < 4; ++j) s[rr] += (yv[rr][j].x * yv[rr][j].x + yv[rr][j].y * yv[rr][j].y) + (yv[rr][j].z * yv[rr][j].z + yv[rr][j].w * yv[rr][j].w);
            const float r = rsqrtf(wave_sum(s[rr]) * (1.f / DM) + EPS);
            float s1 = 0.f;
#pragma unroll
            for (int j = 0; j < 4; ++j) { xv[rr][j] = xv[rr][j] + yv[rr][j] * r * gp[j];
                s1 += (xv[rr][j].x * xv[rr][j].x + xv[rr][j].y * xv[rr][j].y) + (xv[rr][j].z * xv[rr][j].z + xv[rr][j].w * xv[rr][j].w); }
            if (FIRST) {
                const float r1 = rsqrtf(wave_sum(s1) * (1.f / DM) + EPS);
                u32x2* o8 = (u32x2*)(xn + (size_t)m * DM) + lane;
                if (lane == 0) rs_out[m] = 1.f / r1;
#pragma unroll
                for (int j = 0; j < 4; ++j) { u32x2 w; w.x = pk2(xv[rr][j].x * r1, xv[rr][j].y * r1); w.y = pk2(xv[rr][j].z * r1, xv[rr][j].w * r1); o8[64 * j] = w; }
            } else {
                f32x4* xo = (f32x4*)(xout + (size_t)m * DM) + lane;
#pragma unroll
                for (int j = 0; j < 4; ++j) __builtin_nontemporal_store(xv[rr][j], xo + 64 * j);
            } } }
    }
}
#define XB_TMO      128
#define XB_XCNT(j)  (256  + 64 * (j))
#define XB_XSUB(j)  (1280 + 64 * (j))
#define XB_XGEN(j)  (2304 + 64 * (j))
#define XB_TOP      3328
#define XB_TOPGEN   3392
#define XCD_BAR_WORDS 3456
#define XB_SPIN_CAP (1u << 18)

__device__ __forceinline__ unsigned xb_ld(unsigned* p)              { return __hip_atomic_load(p, __ATOMIC_RELAXED, __HIP_MEMORY_SCOPE_AGENT); }
__device__ __forceinline__ unsigned xb_add(unsigned* p, unsigned v) { return __hip_atomic_fetch_add(p, v, __ATOMIC_RELAXED, __HIP_MEMORY_SCOPE_AGENT); }
__device__ __forceinline__ unsigned xb_xcc_id() { return (unsigned)__builtin_amdgcn_s_getreg((3 << 11) | 20) & 0xFu; }
#define XB_SPIN(cond, bar) do { unsigned _sp = 0; while (cond) { __builtin_amdgcn_s_sleep(1); \
    if ((++_sp & 255u) == 0u) { if (xb_ld(&(bar)[XB_TMO])) break; if (_sp > XB_SPIN_CAP) { atomicAdd(&(bar)[XB_TMO], 1u); break; } } } } while (0)

struct XcdBarrier {
    unsigned* bar; unsigned x, nloc, nx;
};

__device__ __forceinline__ void xcd_barrier_complete(unsigned* bar, unsigned x, unsigned& nloc, unsigned& nx) {
    const unsigned G = gridDim.x * gridDim.y * gridDim.z;
    unsigned sum, cnt, mine, sp = 0u;
    for (;;) {
        sum = 0u; cnt = 0u; mine = 0u;
#pragma unroll
        for (unsigned j = 0; j < 16; ++j) { const unsigned c = xb_ld(&bar[XB_XCNT(j)]); sum += c; cnt += (c > 0u) ? 1u : 0u; mine = (j == x) ? c : mine; }
        if (sum == G) break;
        __builtin_amdgcn_s_sleep(1);
        if ((++sp & 255u) == 0u) { if (xb_ld(&bar[XB_TMO])) break; if (sp > XB_SPIN_CAP) { atomicAdd(&bar[XB_TMO], 1u); break; } }
    }
    nloc = mine > 0u ? mine : 1u; nx = cnt > 0u ? cnt : 1u;
}

__device__ __forceinline__ void xcd_barrier(const XcdBarrier& b) {
    asm volatile("s_waitcnt vmcnt(0)" ::: "memory");
    __syncthreads();
    if (threadIdx.x == 0) {
        unsigned* bar = b.bar;
        __builtin_amdgcn_s_waitcnt(0);
        const unsigned nloc = b.nloc, nx = b.nx;
        const unsigned old = xb_add(&bar[XB_XSUB(b.x)], 1u);
        const unsigned gen = old / nloc;
        if (old + 1u == (gen + 1u) * nloc) {
            __builtin_amdgcn_fence(__ATOMIC_RELEASE, "agent");
            asm volatile("s_waitcnt vmcnt(0)" ::: "memory");
            const unsigned og = xb_add(&bar[XB_TOP], 1u);
            const unsigned tg = og / nx;
            if (og + 1u == (tg + 1u) * nx) xb_add(&bar[XB_TOPGEN], 1u);
            else XB_SPIN(xb_ld(&bar[XB_TOPGEN]) == tg, bar);
            __builtin_amdgcn_fence(__ATOMIC_ACQUIRE, "agent");
            xb_add(&bar[XB_XGEN(b.x)], 1u);
            asm volatile("s_waitcnt vmcnt(0)" ::: "memory");
        } else {
            XB_SPIN(xb_ld(&bar[XB_XGEN(b.x)]) == gen, bar);
            __builtin_amdgcn_fence(__ATOMIC_ACQUIRE, "agent");
            asm volatile("s_waitcnt vmcnt(0)" ::: "memory");
        }
    }
    __syncthreads();
}
__device__ __forceinline__ XcdBarrier xcd_barrier_init(unsigned* bar, volatile LAS unsigned* tmp) {
    XcdBarrier b; b.bar = bar; b.x = xb_xcc_id();
    if (threadIdx.x == 0) { (void)xb_add(&bar[XB_XCNT(b.x)], 1u); unsigned nloc, nx; xcd_barrier_complete(bar, b.x, nloc, nx); tmp[0] = nloc; tmp[1] = nx; }
    __syncthreads();
    b.nloc = (unsigned)__builtin_amdgcn_readfirstlane((int)tmp[0]); b.nx = (unsigned)__builtin_amdgcn_readfirstlane((int)tmp[1]);
    __syncthreads();
    return b;
}


constexpr int KT_BYTES = 64 * 256, VT_BYTES = 128 * 128, NBUF = 3, LDS_VOFF = NBUF * KT_BYTES, LDS_QOFF = NBUF * (KT_BYTES + VT_BYTES);
typedef short v4i16_t __attribute__((ext_vector_type(4)));
__device__ __forceinline__ v4i16_t vtr16(const LAS unsigned char* p) { return __builtin_amdgcn_ds_read_tr16_b64_v4i16((LAS v4i16_t*)p); }
__device__ __forceinline__ int pi32(int i) { return (i & ~12) | ((i & 4) << 1) | ((i & 8) >> 1); }
__device__ __forceinline__ float hmax32(float v) { auto rr = __builtin_amdgcn_permlane32_swap(__float_as_uint(v), __float_as_uint(v), false, false); return fmaxf(__uint_as_float(rr[0]), __uint_as_float(rr[1])); }
__device__ __forceinline__ float hsum32(float v) { auto rr = __builtin_amdgcn_permlane32_swap(__float_as_uint(v), __float_as_uint(v), false, false); return __uint_as_float(rr[0]) + __uint_as_float(rr[1]); }

template <bool DIAG>
__device__ __forceinline__ void attn_sub(f32x16 (&O)[2][4], const LAS unsigned char* qlds, float (&mrun)[2], float (&lrun)[2],
                                         const LAS unsigned char* const (&kptr)[2][4], const LAS unsigned char* const (&vptr)[4][2], int koff, int voff, const f32x16& cinit, float cb, int j32, int hi, bool isdiag) {
    f32x16 x0, x1;
#pragma unroll
    for (int sh = 0; sh < 2; ++sh) {
        bf16x8 kf[2][2], qv[2][2];
#pragma unroll
        for (int c = 0; c < 2; ++c)
#pragma unroll
            for (int s2 = 0; s2 < 2; ++s2) { kf[c][s2] = *(const LAS bf16x8*)(kptr[c][sh * 2 + s2] + koff); qv[c][s2] = *(const LAS bf16x8*)(qlds + (c * 4 + sh * 2 + s2) * 1024); }
        if (sh == 0) {
            x0 = __builtin_amdgcn_mfma_f32_32x32x16_bf16(kf[0][0], qv[0][0], cinit, 0, 0, 0); x1 = __builtin_amdgcn_mfma_f32_32x32x16_bf16(kf[1][0], qv[1][0], cinit, 0, 0, 0);
            x0 = __builtin_amdgcn_mfma_f32_32x32x16_bf16(kf[0][1], qv[0][1], x0, 0, 0, 0); x1 = __builtin_amdgcn_mfma_f32_32x32x16_bf16(kf[1][1], qv[1][1], x1, 0, 0, 0);
        } else {
#pragma unroll
            for (int s2 = 0; s2 < 2; ++s2) { x0 = __builtin_amdgcn_mfma_f32_32x32x16_bf16(kf[0][s2], qv[0][s2], x0, 0, 0, 0); x1 = __builtin_amdgcn_mfma_f32_32x32x16_bf16(kf[1][s2], qv[1][s2], x1, 0, 0, 0); }
        }
        __builtin_amdgcn_sched_barrier(0);
    }
    if (isdiag) {
#pragma unroll
        for (int r = 0; r < 16; ++r) { const int kk = 16 * (r >> 3) + 8 * hi + (r & 7); if (kk > j32) { x0[r] = -INFINITY; x1[r] = -INFINITY; } } }
    float mx0 = fmaxf(x0[0], x0[1]), mx1 = fmaxf(x1[0], x1[1]);
#pragma unroll
    for (int r = 2; r < 16; r += 2) { mx0 = fmaxf(fmaxf(mx0, x0[r]), x0[r + 1]); mx1 = fmaxf(fmaxf(mx1, x1[r]), x1[r + 1]); }
    const float mc0 = hmax32(mx0) + cb, mc1 = hmax32(mx1) + cb;
    if (__any((mc0 > mrun[0] + 8.f) || (mc1 > mrun[1] + 8.f))) {
        const float mn0 = fmaxf(mrun[0], mc0), al0 = __builtin_amdgcn_exp2f(mrun[0] - mn0), mn1 = fmaxf(mrun[1], mc1), al1 = __builtin_amdgcn_exp2f(mrun[1] - mn1);
        lrun[0] *= al0; lrun[1] *= al1; mrun[0] = mn0; mrun[1] = mn1;
#pragma unroll
        for (int dt = 0; dt < 4; ++dt)
#pragma unroll
            for (int r = 0; r < 16; ++r) { O[0][dt][r] *= al0; O[1][dt][r] *= al1; }
    }
    const float off0 = cb - mrun[0], off1 = cb - mrun[1];
    float ls0 = 0.f, ls1 = 0.f;
#pragma unroll
    for (int r = 0; r < 16; ++r) { x0[r] = __builtin_amdgcn_exp2f(x0[r] + off0); ls0 += x0[r]; x1[r] = __builtin_amdgcn_exp2f(x1[r] + off1); ls1 += x1[r]; }
    lrun[0] += ls0; lrun[1] += ls1;
    bf16x8 p0[2], p1[2];
#pragma unroll
    for (int t = 0; t < 2; ++t) {
        p0[t] = __builtin_bit_cast(bf16x8, (u32x4){pk2(x0[8 * t], x0[8 * t + 1]), pk2(x0[8 * t + 2], x0[8 * t + 3]), pk2(x0[8 * t + 4], x0[8 * t + 5]), pk2(x0[8 * t + 6], x0[8 * t + 7])});
        p1[t] = __builtin_bit_cast(bf16x8, (u32x4){pk2(x1[8 * t], x1[8 * t + 1]), pk2(x1[8 * t + 2], x1[8 * t + 3]), pk2(x1[8 * t + 4], x1[8 * t + 5]), pk2(x1[8 * t + 6], x1[8 * t + 7])}); }
#pragma unroll
    for (int dt = 0; dt < 4; ++dt) {
        bf16x8 vf[2];
#pragma unroll
        for (int t = 0; t < 2; ++t) { const v4i16_t lo_ = vtr16(vptr[dt][0] + voff + t * 4096), hi_ = vtr16(vptr[dt][1] + voff + t * 4096);
            vf[t] = (bf16x8){lo_[0], lo_[1], lo_[2], lo_[3], hi_[0], hi_[1], hi_[2], hi_[3]}; }
#pragma unroll
        for (int t = 0; t < 2; ++t) {
            O[0][dt] = __builtin_amdgcn_mfma_f32_32x32x16_bf16(vf[t], p0[t], O[0][dt], 0, 0, 0);
            O[1][dt] = __builtin_amdgcn_mfma_f32_32x32x16_bf16(vf[t], p1[t], O[1][dt], 0, 0, 0); }
    }
}

__device__ __forceinline__ void attn_unit(LAS unsigned char* lds, int b, int h, int qb, const bf16_t* Qb, const bf16_t* Kb, const bf16_t* VT, const bf16_t* Zs, bf16_t* og,
                                          const float* gsub, float lam) {
    const int tid = threadIdx.x, lane = tid & 63, j32 = lane & 31, hi = lane >> 5; const int wid = __builtin_amdgcn_readfirstlane(tid >> 6);
    const float sl2 = exp2f(-(float)(h + 1)) * LOG2E;
    const size_t tokbase = (size_t)b * SEQ;
    const int q0w = qb * 256 + wid * 32, qpos = q0w + j32;
    LAS unsigned char* qlds = lds + LDS_QOFF + wid * 8192 + lane * 16;
    { const bf16_t* qp = Qb + (tokbase + qpos) * 1024 + h * 128 + hi * 8;
#pragma unroll
      for (int c = 0; c < 2; ++c)
#pragma unroll
          for (int s = 0; s < 4; ++s) *(LAS bf16x8*)(qlds + (c * 4 + s) * 1024) = *(const bf16x8*)(qp + c * 64 + s * 16); }
    f32x16 O[2][4];
#pragma unroll
    for (int c = 0; c < 2; ++c)
#pragma unroll
        for (int dt = 0; dt < 4; ++dt)
#pragma unroll
            for (int r = 0; r < 16; ++r) O[c][dt][r] = 0.f;
    float mrun[2] = {-1e30f, -1e30f}, lrun[2] = {0.f, 0.f};
    f32x16 cinit;
    { int hio = hi; asm volatile("" : "+v"(hio));
#pragma unroll
      for (int r = 0; r < 16; ++r) cinit[r] = sl2 * (float)(16 * (r >> 3) + 8 * hio + (r & 7)); }
    const int nsub_w = qb * 8 + wid + 1, NT = 4 * qb + 4;
    const bf16_t* Kbh = Kb + tokbase * 1024 + h * 128;
    const bf16_t* Vbh = VT + tokbase * 1024 + h * 128;
    unsigned kgo[2], vgo[2];
#pragma unroll
    for (int i = 0; i < 2; ++i) { const int kr = 4 * (2 * wid + i) + (lane >> 4), vr = 8 * (2 * wid + i) + (lane >> 3);
        kgo[i] = (unsigned)(kr * 1024 + (((lane & 15) ^ (kr & 15)) * 8)) * 2u;
        vgo[i] = (unsigned)(kr * 1024 + (((lane & 15) ^ (((kr & 3) << 2) | ((kr >> 2) & 3))) * 8)) * 2u; (void)vr; }
#define DMAT(kt, bf) do { const char* kb_ = (const char*)Kbh + (size_t)(unsigned)__builtin_amdgcn_readfirstlane((kt) * 131072); \
        const char* vb_ = (const char*)Vbh + (size_t)(unsigned)__builtin_amdgcn_readfirstlane((kt) * 131072); \
        _Pragma("unroll") for (int i_ = 0; i_ < 2; ++i_) { \
        __builtin_amdgcn_global_load_lds((const unsigned*)(kb_ + kgo[i_]), (LAS unsigned*)(lds + (bf) * KT_BYTES + (2 * wid + i_) * 1024), 16, 0, 0); \
        __builtin_amdgcn_global_load_lds((const unsigned*)(vb_ + vgo[i_]), (LAS unsigned*)(lds + LDS_VOFF + (bf) * VT_BYTES + (2 * wid + i_) * 1024), 16, 0, 0); } } while (0)
    const int krow = pi32(j32);
    const int kbase = krow * 256 + (((krow & 15) ^ hi) << 4);
    const int vbase = j32 * 128 + ((((j32 >> 1) & 7) ^ hi) << 4);
    const LAS unsigned char* kptr[2][4]; const LAS unsigned char* vptr[4][2];
#pragma unroll
    for (int c = 0; c < 2; ++c)
#pragma unroll
        for (int s_ = 0; s_ < 4; ++s_) kptr[c][s_] = lds + (kbase ^ ((c * 8 + s_ * 2) << 4));
    {
      const int q_ = (lane >> 2) & 3, p_ = lane & 3, g_ = (lane >> 4) & 1;
#pragma unroll
      for (int dt = 0; dt < 4; ++dt)
#pragma unroll
          for (int h4 = 0; h4 < 2; ++h4) { const int row_ = 8 * hi + 4 * h4 + q_, f_ = (q_ << 2) | ((2 * hi + h4) & 3), ch_ = dt * 4 + g_ * 2 + (p_ >> 1);
              vptr[dt][h4] = lds + LDS_VOFF + 256 * row_ + 16 * (ch_ ^ f_) + 8 * (p_ & 1); } }
#define WAIT_BAR(N) asm volatile("s_waitcnt vmcnt(" #N ") lgkmcnt(0)\n\ts_barrier" ::: "memory")
    asm volatile("s_waitcnt vmcnt(0)" ::: "memory");
    DMAT(NT - 1, 0); DMAT(NT - 2, 1);
#pragma unroll 1
    for (int it0 = 0; it0 < NT; it0 += NBUF) {
#pragma unroll
        for (int buf = 0; buf < NBUF; ++buf) {
            const int it = it0 + buf;
            if (it < NT) {
                const int kt = NT - 1 - it;
                if (it + 1 < NT) WAIT_BAR(4); else WAIT_BAR(0);
                if (it + 2 < NT) DMAT(kt - 2, (buf + 2) % NBUF);
#pragma unroll
                for (int st = 1; st >= 0; --st) {
                    const int sub = 2 * kt + st;
                    if (sub < nsub_w) {
                        const float cb = sl2 * (float)(sub * 32 - qpos);
                        attn_sub<true>(O, qlds, mrun, lrun, kptr, vptr, buf * KT_BYTES + st * 8192, buf * VT_BYTES + st * 8192, cinit, cb, j32, hi, sub == nsub_w - 1);
                    }
                }
            }
        }
    }
    asm volatile("s_waitcnt lgkmcnt(0)\n\ts_barrier" ::: "memory");
#undef WAIT_BAR
#undef DMAT
    const float inv0 = 1.f / hsum32(lrun[0]), k1 = -lam / hsum32(lrun[1]);
    float ss = 0.f;
#pragma unroll
    for (int dt = 0; dt < 4; ++dt)
#pragma unroll
        for (int r = 0; r < 16; ++r) { const float o = O[0][dt][r] * inv0 + O[1][dt][r] * k1; O[0][dt][r] = o; ss += o * o; }
    const float rs = rsqrtf(hsum32(ss) * (1.f / 128.f) + EPS) * (1.f - LAM_INIT);
    int hie = hi, qpe = qpos; asm volatile("" : "+v"(hie), "+v"(qpe));
    const size_t orow = (tokbase + qpe) * 1024 + h * 128;
#pragma unroll
    for (int dt = 0; dt < 4; ++dt)
#pragma unroll
        for (int rq = 0; rq < 4; ++rq) { const int dv = 32 * dt + 8 * rq + 4 * hie;
            const f32x4 gs = *(const f32x4*)(gsub + dv); const u32x2 zz = *(const u32x2*)(Zs + orow + dv);
            u32x2 w; w.x = pk2(O[0][dt][4 * rq] * rs * gs.x * bflo(zz.x), O[0][dt][4 * rq + 1] * rs * gs.y * bfhi(zz.x));
            w.y = pk2(O[0][dt][4 * rq + 2] * rs * gs.z * bflo(zz.y), O[0][dt][4 * rq + 3] * rs * gs.w * bfhi(zz.y));
            *(u32x2*)(og + orow + dv) = w; }
}

__device__ __forceinline__ void attn_phase(LAS unsigned char* lds, const bf16_t* Qb, const bf16_t* Kb, const bf16_t* VT, const bf16_t* Zs, bf16_t* og, const float* gsub, float lam) {
    for (int vb = blockIdx.x; vb < 256; vb += gridDim.x) {
        const int bh = vb & 127, half = vb >> 7;
#pragma unroll 1
        for (int ui = 0; ui < 4; ++ui) {
            const int qb = half == 0 ? (ui == 0 ? 7 : ui == 1 ? 0 : ui == 2 ? 5 : 2) : (ui == 0 ? 6 : ui == 1 ? 1 : ui == 2 ? 4 : 3);
            attn_unit(lds, bh >> 3, bh & 7, qb, Qb, Kb, VT, Zs, og, gsub, lam);
        }
    }
}

#ifndef REP_PH
#define REP_PH -1
#endif
#ifndef REP_N
#define REP_N 1
#endif
#define NREP(k) ((k) == REP_PH ? REP_N : 1)
#ifndef N_CG_SYNC
#define N_CG_SYNC 0
#endif
#ifndef MK_MULTI
#define MK_MULTI 0
#endif
__global__ void __launch_bounds__(NTHREADS, 2) yoco_fwd(Args a) {
    extern __shared__ __attribute__((aligned(16))) unsigned char lds_raw[];
    LAS unsigned char* lds = (LAS unsigned char*)lds_raw;
    cg::grid_group grid = cg::this_grid();
    const int tid = threadIdx.x, lane = tid & 63, wave = __builtin_amdgcn_readfirstlane(tid >> 6);
    const int lo = a.ph_lo, hi = a.ph_hi;
    const XcdBarrier xbar = xcd_barrier_init((unsigned*)(a.ws + WS_CTL), (volatile LAS unsigned*)lds);
    unsigned char* ws = a.ws;
    bf16_t* SA = (bf16_t*)(ws + WS_A); bf16_t* SB = (bf16_t*)(ws + WS_B); bf16_t* SC = (bf16_t*)(ws + WS_C); bf16_t* SF = (bf16_t*)(ws + WS_F); bf16_t* SG = (bf16_t*)(ws + WS_G); bf16_t* SH = (bf16_t*)(ws + WS_H);
#define IN(k) (lo <= (k) && (k) < hi)
#define SEAM(k) do { if (IN(k) && IN((k) + 1)) { if ((k) < N_CG_SYNC) grid.sync(); else xcd_barrier(xbar); } } while (0)
    if (lo > hi) grid.sync();
    if (IN(0)) { for (int rep = 0; rep < NREP(0); ++rep) p0_phase(a, lds, lane, wave); }
    SEAM(0);
    if (IN(1)) {
        pg8::Gemm g{SA, (const bf16_t*)(ws + WS_WT1), MTOK, 3072, 1024}; pg8::StaticOrder S; S.init(MTOK, 3072, gridDim.x, blockIdx.x); S.rep = NREP(1);
        pg8::EpiGlu E{SB, SC};
        pg8::gemm_phase<pg8::EpiGlu, pg8::StaticOrder, true, true>(lds, g, S, E);
    }
    SEAM(1);
    if (IN(2)) { for (int rep = 0; rep < NREP(2); ++rep) conv_phase(lds, SB, SC, SH, a.in[3], a.in[4], a.in[5], a.in[6]); }
    SEAM(2);
    if (IN(3)) {
        pg8::Gemm g{SH, (const bf16_t*)(ws + WS_WT2), MTOK, 1024, 1024}; pg8::StaticOrder S; S.init(MTOK, 1024, gridDim.x, blockIdx.x); S.rep = NREP(3);
        pg8::EpiPlain E{SB, 1024, 1.f};
        pg8::gemm_phase<pg8::EpiPlain, pg8::StaticOrder, true, true>(lds, g, S, E);
    }
    SEAM(3);
    if (IN(4)) { for (int rep = 0; rep < NREP(4); ++rep) resid_phase<true>(SA, (const float*)(ws + WS_RS0), SB, a.in[8], nullptr, (float*)(ws + WS_RS), SH, lane, wave); }
    SEAM(4);
    if (IN(5)) {
        {
            static_assert(WS_WT3V == WS_WT3 + (size_t)3072 * 1024 * 2 && WS_G - WS_F == WS_C - WS_B, "K|Q|Z|V weights contiguous, output slots equally spaced");
            pg8::Gemm g{SH, (const bf16_t*)(ws + WS_WT3), MTOK, 4096, 1024}; pg8::StaticOrder S; S.init(MTOK, 4096, gridDim.x, blockIdx.x); S.rep = NREP(5);
            pg8::EpiKQZ E{SB, (size_t)(WS_C - WS_B) / 2, 0.125f * LOG2E};   static_assert(WS_C - WS_B == WS_F - WS_C, "K|Q|Z slots equally spaced");
            pg8::gemm_phase<pg8::EpiKQZ, pg8::StaticOrder, true, true>(lds, g, S, E);
        }
    }
    SEAM(5);
    if (IN(6)) {
        const float* lp = a.in[13];
        const float sa = wave_sum(lp[lane] * lp[64 + lane]), sb = wave_sum(lp[128 + lane] * lp[192 + lane]);
        const float lam = expf(sa) - expf(sb) + LAM_INIT;
        for (int rep = 0; rep < NREP(6); ++rep) attn_phase(lds, SC, SB, SG, SF, SA, a.in[14], lam);
    }
    SEAM(6);
    if (IN(7)) {
        pg8::Gemm g{SA, (const bf16_t*)(ws + WS_WT4), MTOK, 1024, 1024}; pg8::StaticOrder S; S.init(MTOK, 1024, gridDim.x, blockIdx.x);
        pg8::EpiPlain E{SB, 1024, 1.f};
        pg8::gemm_phase<pg8::EpiPlain, pg8::StaticOrder, true, true>(lds, g, S, E);
    }
    SEAM(7);
    if (IN(8)) { resid_phase<false>(SH, (const float*)(ws + WS_RS), SB, a.in[16], a.out, nullptr, nullptr, lane, wave); }
#undef IN
#undef SEAM
}

extern "C" void kernel_launch(void* const* d_in, const int* in_sizes, int n_in, void* d_out, int out_size, void* d_ws, size_t ws_size, hipStream_t stream) {
    static int grid = 0;
    if (grid == 0) {
        if (n_in != 17 || in_sizes[0] != MTOK * DM || out_size != MTOK * DM || ws_size < WS_END) {
            fprintf(stderr, "kernel_launch: unexpected shapes (n_in %d in0 %d out %d ws %zu)\n", n_in, n_in > 0 ? in_sizes[0] : -1, out_size, ws_size); grid = -1; return; }
        int dev = 0, cus = 0, per_cu = 0;
        hipGetDevice(&dev);
        hipDeviceGetAttribute(&cus, hipDeviceAttributeMultiprocessorCount, dev);
        if (hipFuncSetAttribute((const void*)yoco_fwd, hipFuncAttributeMaxDynamicSharedMemorySize, LDS_BYTES) != hipSuccess) fprintf(stderr, "kernel_launch: hipFuncSetAttribute failed\n");
        if (hipOccupancyMaxActiveBlocksPerMultiprocessor(&per_cu, (const void*)yoco_fwd, NTHREADS, LDS_BYTES) != hipSuccess || per_cu < 1) {
            fprintf(stderr, "kernel_launch: occupancy query says %d blocks/CU\n", per_cu); per_cu = 1; }
        (void)hipGetLastError();
        grid = cus * per_cu; if (grid > 256) grid = 256;
        fprintf(stderr, "kernel_launch: grid %d (cus %d, per_cu %d)\n", grid, cus, per_cu);
    }
    if (grid < 0) return;
    if (hipMemsetAsync((char*)d_ws + WS_CTL, 0, CTL_BYTES, stream) != hipSuccess) fprintf(stderr, "kernel_launch: memset of the barrier words failed\n");
    Args a{};
    for (int i = 0; i < 17; ++i) a.in[i] = (const float*)d_in[i];
    a.out = (float*)d_out; a.ws = (unsigned char*)d_ws;
#if MK_MULTI
    for (int p = 0; p < 9; ++p) { a.ph_lo = p; a.ph_hi = p + 1; hipLaunchKernelGGL(yoco_fwd, dim3(grid), dim3(NTHREADS), LDS_BYTES, stream, a); }
#else
    a.ph_lo = 0; a.ph_hi = 9;
    void* args[] = {&a};
    hipError_t e = hipLaunchCooperativeKernel((const void*)yoco_fwd, dim3(grid), dim3(NTHREADS), args, LDS_BYTES, stream);
    if (e != hipSuccess) fprintf(stderr, "cooperative launch failed: %s (grid %d)\n", hipGetErrorString(e), grid);
#endif
}
```

```cpp
#include <hip/hip_runtime.h>
#include <hip/hip_cooperative_groups.h>
#include <cstdio>
#include <cstdint>
namespace cg = cooperative_groups;
namespace pg8 {
#define PG8_LAS __attribute__((address_space(3)))
typedef unsigned short bf16_t;
typedef short bf16x8 __attribute__((ext_vector_type(8)));
typedef float f32x4 __attribute__((ext_vector_type(4)));
typedef unsigned u32x4 __attribute__((ext_vector_type(4)));
constexpr int BM = 256, BK = 64, HALF = 128, HTB = HALF * BK * 2  , STAGE_BYTES = 8 * HTB, NXCD = 8, WGM = 8;

__host__ __device__ __forceinline__ int lds_byte(int r, int c) { const int st = (r >> 4) * 2 + (c >> 5), rr = r & 15, cc = c & 31, ob = rr * 64 + cc * 2; return st * 1024 + (ob ^ (((ob >> 9) & 1) << 5)); }
__host__ __device__ __forceinline__ void stage_rc(int b, int& R, int& C) { const int st = b / 1024, sb = b % 1024, swz = sb ^ (((sb >> 9) & 1) << 5); R = (st >> 1) * 16 + swz / 64; C = (st & 1) * 32 + (swz % 64) / 2; }
__host__ __device__ __forceinline__ int perm32(int rho) { const int n = rho >> 4, i = rho & 15; return 8 * (i >> 2) + 4 * n + (i & 3); }

struct Unit { int pm, pn; };
struct Gemm { const bf16_t* A; const bf16_t* Bt; int M, N, K; };

struct StaticOrder {
    int nM, nN, nwg, G, c, rep = 1;
    __host__ __device__ void init(int M, int N, int G_, int c_) { nM = M / BM; nN = N / BM; nwg = nM * nN; G = G_; c = c_; }
    __host__ __device__ bool next(int i, Unit& u) const {
        long L = (long)i * G + c; if (L >= (long)nwg * rep) return false;
        if (L >= nwg) L -= nwg;
        int wgid = (int)L; { const int q = nwg / NXCD, r = nwg % NXCD, xcd = wgid % NXCD, off = wgid / NXCD; wgid = (xcd < r ? xcd * (q + 1) : r * (q + 1) + (xcd - r) * q) + off; }
        const int nig = WGM * nN, gid = wgid / nig, fm = gid * WGM, gsz = (nM - fm) < WGM ? (nM - fm) : WGM;
        u.pm = fm + ((wgid % nig) % gsz); u.pn = (wgid % nig) / gsz; return true;
    }
    __device__ __forceinline__ void a_ready(const Unit&) const {}
    __device__ __forceinline__ void done(const Unit&) const {}
};

typedef float f32x2 __attribute__((ext_vector_type(2)));
typedef __bf16 bf16x2c __attribute__((ext_vector_type(2)));
__device__ __forceinline__ unsigned cvt_pk_bf16(float lo, float hi) { const f32x2 v = {lo, hi}; const bf16x2c b = __builtin_convertvector(v, bf16x2c); return __builtin_bit_cast(unsigned, b); }
template <class Epi, class Sched, bool ALIGN_EPI = false, bool SP2 = false>
__device__ __forceinline__ void gemm_phase(PG8_LAS unsigned char* lds, const Gemm g, const Sched& S, const Epi& E) {
    const int tid = threadIdx.x, wid = __builtin_amdgcn_readfirstlane(tid >> 6), lane = tid & 63, wr = wid >> 2, wc = wid & 3, fr = lane & 15, fq = lane >> 4;
    const int K = g.K, nt = K / BK;
    unsigned voffA[2], voffB[2];
#pragma unroll
    for (int i = 0; i < 2; ++i) { int R, C; stage_rc(tid * 16 + i * 8192, R, C); const int Rb = Epi::PERM ? ((R & ~31) + perm32(R & 31)) : R;
        voffA[i] = (unsigned)(R * K + C) * 2u; voffB[i] = (unsigned)(Rb * K + C) * 2u; }
    const size_t kstep = (size_t)(BK * 2);
    const size_t hstep = (size_t)HALF * K * 2;
    const size_t tstep = 2 * hstep;
    const unsigned ldsw = (unsigned)wid * 1024u;
    const int aoff = lds_byte(wr * 64 + fr, fq * 8), boff = lds_byte(wc * 32 + fr, fq * 8);
#define PG8_SA(b, h) (((b) * 2 + (h)) * HTB)
#define PG8_SB(b, h) ((4 + (b) * 2 + (h)) * HTB)
#define PG8_STAGE(bufoff, gbase, voff) do { _Pragma("unroll") for (int _i = 0; _i < 2; ++_i) \
        __builtin_amdgcn_global_load_lds((const unsigned*)((const char*)(gbase) + (voff)[_i]), (PG8_LAS unsigned*)(lds + (bufoff) + ldsw + _i * 8192), 16, 0, 0); } while (0)
#define PG8_LDA(dst, b, h) do { _Pragma("unroll") for (int m = 0; m < 4; ++m) _Pragma("unroll") for (int k = 0; k < 2; ++k) dst[m][k] = *(const PG8_LAS bf16x8*)(lds + PG8_SA(b, h) + aoff + m * 2048 + k * 1024); } while (0)
#define PG8_LDB(dst, b, h) do { _Pragma("unroll") for (int n = 0; n < 2; ++n) _Pragma("unroll") for (int k = 0; k < 2; ++k) dst[n][k] = *(const PG8_LAS bf16x8*)(lds + PG8_SB(b, h) + boff + n * 2048 + k * 1024); } while (0)
#define PG8_MMA(ai, bj, At, Bt) do { __builtin_amdgcn_s_setprio(1); _Pragma("unroll") for (int m = 0; m < 4; ++m) _Pragma("unroll") for (int n = 0; n < 2; ++n) _Pragma("unroll") for (int k = 0; k < 2; ++k) \
        acc[ai][bj][m][n] = __builtin_amdgcn_mfma_f32_16x16x32_bf16(Bt[n][k], At[m][k], acc[ai][bj][m][n], 0, 0, 0); __builtin_amdgcn_s_setprio(0); } while (0)
#define PG8_WAIT_V(n) asm volatile("s_waitcnt vmcnt(" #n ")" ::: "memory")
#define PG8_WAIT_L(n) asm volatile("s_waitcnt lgkmcnt(" #n ")" ::: "memory")
#define PG8_BAR __builtin_amdgcn_s_barrier()
#define PG8_SCHED __builtin_amdgcn_sched_barrier(0)
    Unit cur, nxt; int ui = 0;
    if (!S.next(0, cur)) return;
    f32x4 acc[2][2][4][2];
#pragma unroll
    for (int a = 0; a < 2; ++a)
#pragma unroll
        for (int b = 0; b < 2; ++b)
#pragma unroll
            for (int m = 0; m < 4; ++m)
#pragma unroll
                for (int n = 0; n < 2; ++n) acc[a][b][m][n] = (f32x4){0.f, 0.f, 0.f, 0.f};
    bf16x8 At[4][2], B0[2][2], B1[2][2];
    const char* cA = (const char*)g.A + (size_t)cur.pm * tstep; const char* cB = (const char*)g.Bt + (size_t)cur.pn * tstep;
    S.a_ready(cur);
    if constexpr (SP2) {
        PG8_STAGE(PG8_SB(0, 0), cB, voffB); PG8_STAGE(PG8_SB(0, 1), cB + hstep, voffB); PG8_STAGE(PG8_SA(0, 0), cA, voffA); PG8_STAGE(PG8_SA(0, 1), cA + hstep, voffA);
        if (wr == 1) PG8_BAR;
        PG8_WAIT_V(2); PG8_BAR;
        PG8_STAGE(PG8_SB(1, 0), cB + kstep, voffB); PG8_STAGE(PG8_SA(1, 0), cA + kstep, voffA); PG8_STAGE(PG8_SB(1, 1), cB + hstep + kstep, voffB);
        PG8_WAIT_V(6); PG8_BAR;
    } else {
        PG8_STAGE(PG8_SB(0, 0), cB, voffB); PG8_STAGE(PG8_SA(0, 0), cA, voffA); PG8_STAGE(PG8_SB(0, 1), cB + hstep, voffB); PG8_STAGE(PG8_SA(0, 1), cA + hstep, voffA);
        if (wr == 1) PG8_BAR;
        PG8_WAIT_V(4); PG8_BAR;
        PG8_STAGE(PG8_SB(1, 0), cB + kstep, voffB); PG8_STAGE(PG8_SA(1, 0), cA + kstep, voffA); PG8_STAGE(PG8_SB(1, 1), cB + hstep + kstep, voffB);
        PG8_WAIT_V(6); PG8_BAR;
    }
    for (;;) {
        const bool has_next = S.next(ui + 1, nxt);
        const char* nA = has_next ? (const char*)g.A + (size_t)nxt.pm * tstep : cA; const char* nB = has_next ? (const char*)g.Bt + (size_t)nxt.pn * tstep : cB;
        for (int t = 0; t < nt; t += 2) {
            const bool last = (t == nt - 2);
            const char* a1 = cA + (size_t)(t + 1) * kstep;
            const char* a2 = last ? nA : cA + (size_t)(t + 2) * kstep; const char* b2 = last ? nB : cB + (size_t)(t + 2) * kstep;
            const char* a3 = a2 + kstep; const char* b3 = b2 + kstep;
            if (last && has_next) S.a_ready(nxt);
            if constexpr (SP2) {
            PG8_LDB(B0, 0, 0); PG8_LDB(B1, 0, 1); PG8_SCHED; PG8_LDA(At, 0, 0); PG8_STAGE(PG8_SA(1, 1), a1 + hstep, voffA);
            PG8_WAIT_V(8); PG8_WAIT_L(0); PG8_BAR; PG8_MMA(0, 0, At, B0); PG8_MMA(0, 1, At, B1); PG8_BAR; PG8_SCHED;
            PG8_LDA(At, 0, 1); PG8_STAGE(PG8_SB(0, 0), b2, voffB); PG8_STAGE(PG8_SB(0, 1), b2 + hstep, voffB); PG8_STAGE(PG8_SA(0, 0), a2, voffA);
            PG8_WAIT_V(8); PG8_WAIT_L(0); PG8_BAR; PG8_MMA(1, 0, At, B0); PG8_MMA(1, 1, At, B1); PG8_BAR; PG8_SCHED;
            PG8_LDB(B0, 1, 0); PG8_LDB(B1, 1, 1); PG8_SCHED; PG8_LDA(At, 1, 0); PG8_STAGE(PG8_SA(0, 1), a2 + hstep, voffA);
            PG8_WAIT_V(8); PG8_WAIT_L(0); PG8_BAR; PG8_MMA(0, 0, At, B0); PG8_MMA(0, 1, At, B1); PG8_BAR; PG8_SCHED;
            PG8_LDA(At, 1, 1); PG8_STAGE(PG8_SB(1, 0), b3, voffB); PG8_STAGE(PG8_SB(1, 1), b3 + hstep, voffB); PG8_STAGE(PG8_SA(1, 0), a3, voffA);
            PG8_WAIT_V(8); PG8_WAIT_L(0); PG8_BAR; PG8_MMA(1, 0, At, B0); PG8_MMA(1, 1, At, B1); PG8_BAR; PG8_SCHED;
            } else {
            PG8_LDB(B0, 0, 0); PG8_SCHED; PG8_LDA(At, 0, 0); PG8_STAGE(PG8_SA(1, 1), a1 + hstep, voffA);
            PG8_WAIT_L(8); PG8_BAR; PG8_WAIT_L(0); PG8_MMA(0, 0, At, B0); PG8_BAR; PG8_SCHED;
            PG8_LDB(B1, 0, 1); PG8_STAGE(PG8_SB(0, 0), b2, voffB);
            PG8_BAR; PG8_WAIT_L(0); PG8_MMA(0, 1, At, B1); PG8_BAR;
            PG8_LDA(At, 0, 1); PG8_STAGE(PG8_SA(0, 0), a2, voffA);
            PG8_BAR; PG8_WAIT_L(0); PG8_MMA(1, 0, At, B0); PG8_BAR; PG8_SCHED;
            PG8_STAGE(PG8_SB(0, 1), b2 + hstep, voffB);
            PG8_WAIT_V(6); PG8_BAR; PG8_MMA(1, 1, At, B1); PG8_BAR;
            PG8_LDB(B0, 1, 0); PG8_SCHED; PG8_LDA(At, 1, 0); PG8_STAGE(PG8_SA(0, 1), a2 + hstep, voffA);
            PG8_WAIT_L(8); PG8_BAR; PG8_WAIT_L(0); PG8_MMA(0, 0, At, B0); PG8_BAR; PG8_SCHED;
            PG8_LDB(B1, 1, 1); PG8_STAGE(PG8_SB(1, 0), b3, voffB);
            PG8_BAR; PG8_WAIT_L(0); PG8_MMA(0, 1, At, B1); PG8_BAR;
            PG8_LDA(At, 1, 1); PG8_STAGE(PG8_SA(1, 0), a3, voffA);
            PG8_BAR; PG8_WAIT_L(0); PG8_MMA(1, 0, At, B0); PG8_BAR; PG8_SCHED;
            PG8_STAGE(PG8_SB(1, 1), b3 + hstep, voffB);
            PG8_WAIT_V(6); PG8_BAR; PG8_MMA(1, 1, At, B1); PG8_BAR;
            }
        }
        if constexpr (ALIGN_EPI) { if (wr == 0) PG8_BAR; }
        if constexpr (!Epi::AFTER_DRAIN) { E(acc, cur, wr, wc, fr, fq); S.done(cur); }
        if (!has_next) break;
#pragma unroll
        for (int a = 0; a < 2; ++a)
#pragma unroll
            for (int b = 0; b < 2; ++b)
#pragma unroll
                for (int m = 0; m < 4; ++m)
#pragma unroll
                    for (int n = 0; n < 2; ++n) acc[a][b][m][n] = (f32x4){0.f, 0.f, 0.f, 0.f};
        cur = nxt; cA = nA; cB = nB; ++ui;
        if constexpr (ALIGN_EPI) { if (wr == 1) PG8_BAR; }
    }
    PG8_WAIT_V(0);
    if constexpr (!ALIGN_EPI) { if (wr == 0) PG8_BAR; }
    PG8_BAR;
    if constexpr (Epi::AFTER_DRAIN) { E.fused(acc, cur, wr, wc, fr, fq, lds, wid, lane); S.done(cur); }
#undef PG8_SA
#undef PG8_SB
#undef PG8_STAGE
#undef PG8_LDA
#undef PG8_LDB
#undef PG8_MMA
#undef PG8_WAIT_V
#undef PG8_WAIT_L
#undef PG8_BAR
#undef PG8_SCHED
}
}

namespace pg8 {
__device__ __forceinline__ float sigm(float v) { return __builtin_amdgcn_rcpf(1.f + __builtin_amdgcn_exp2f(-1.4426950408889634f * v)); }
struct EpiPlain {
    static constexpr bool PERM = true, AFTER_DRAIN = false;
    bf16_t* O; int ldc; float scale;
    __device__ __forceinline__ void operator()(const f32x4 (&acc)[2][2][4][2], const Unit& u, int wr, int wc, int fr, int fq) const {
        const int row0 = u.pm * BM + wr * 64 + fr, col0 = u.pn * BM + wc * 32 + 8 * fq;
#pragma unroll
        for (int ai = 0; ai < 2; ++ai)
#pragma unroll
            for (int m = 0; m < 4; ++m) { bf16_t* rowp = O + (size_t)(row0 + ai * HALF + m * 16) * ldc + col0;
#pragma unroll
                for (int bj = 0; bj < 2; ++bj) { const f32x4 v0 = acc[ai][bj][m][0] * scale, v1 = acc[ai][bj][m][1] * scale;
                    u32x4 w; w.x = cvt_pk_bf16(v0[0], v0[1]); w.y = cvt_pk_bf16(v0[2], v0[3]); w.z = cvt_pk_bf16(v1[0], v1[1]); w.w = cvt_pk_bf16(v1[2], v1[3]);
                    *(u32x4*)(rowp + bj * HALF) = w; } }
    }
};
struct EpiGlu {
    static constexpr bool PERM = true, AFTER_DRAIN = false;
    bf16_t* G; bf16_t* SZ;
    __device__ __forceinline__ void operator()(const f32x4 (&acc)[2][2][4][2], const Unit& u, int wr, int wc, int fr, int fq) const {
        const int row0 = u.pm * BM + wr * 64 + fr;
        if (u.pn < 8) {
            const int col0 = u.pn * HALF + wc * 32 + 8 * fq;
#pragma unroll
            for (int ai = 0; ai < 2; ++ai)
#pragma unroll
                for (int m = 0; m < 4; ++m) { bf16_t* rowp = G + (size_t)(row0 + ai * HALF + m * 16) * 1024 + col0;
                    f32x4 v0, v1;
#pragma unroll
                    for (int j = 0; j < 4; ++j) { v0[j] = acc[ai][0][m][0][j] * sigm(acc[ai][1][m][0][j]); v1[j] = acc[ai][0][m][1][j] * sigm(acc[ai][1][m][1][j]); }
                    u32x4 w; w.x = cvt_pk_bf16(v0[0], v0[1]); w.y = cvt_pk_bf16(v0[2], v0[3]); w.z = cvt_pk_bf16(v1[0], v1[1]); w.w = cvt_pk_bf16(v1[2], v1[3]);
                    *(u32x4*)rowp = w; }
        } else {
            const int col0 = (u.pn - 8) * BM + wc * 32 + 8 * fq;
#pragma unroll
            for (int ai = 0; ai < 2; ++ai)
#pragma unroll
                for (int m = 0; m < 4; ++m) { bf16_t* rowp = SZ + (size_t)(row0 + ai * HALF + m * 16) * 1024 + col0;
#pragma unroll
                    for (int bj = 0; bj < 2; ++bj) { f32x4 v0 = acc[ai][bj][m][0], v1 = acc[ai][bj][m][1];
#pragma unroll
                        for (int j = 0; j < 4; ++j) { v0[j] = v0[j] * sigm(v0[j]); v1[j] = v1[j] * sigm(v1[j]); }
                        u32x4 w; w.x = cvt_pk_bf16(v0[0], v0[1]); w.y = cvt_pk_bf16(v0[2], v0[3]); w.z = cvt_pk_bf16(v1[0], v1[1]); w.w = cvt_pk_bf16(v1[2], v1[3]);
                        *(u32x4*)(rowp + bj * HALF) = w; } }
        }
    }
};
struct EpiKQZ {
    static constexpr bool PERM = true, AFTER_DRAIN = false;
    bf16_t* Kb; size_t seg_stride; float qscale;
    __device__ __forceinline__ void operator()(const f32x4 (&acc)[2][2][4][2], const Unit& u, int wr, int wc, int fr, int fq) const {
        const int row0 = u.pm * BM + wr * 64 + fr; const int seg = u.pn >> 2;
        bf16_t* base = Kb + (size_t)seg * seg_stride;
        const float sc = seg == 1 ? qscale : 1.f;
        const int col0 = (u.pn & 3) * BM + wc * 32 + 8 * fq;
#pragma unroll
        for (int ai = 0; ai < 2; ++ai)
#pragma unroll
            for (int m = 0; m < 4; ++m) { bf16_t* rowp = base + (size_t)(row0 + ai * HALF + m * 16) * 1024 + col0;
#pragma unroll
                for (int bj = 0; bj < 2; ++bj) { f32x4 v0 = acc[ai][bj][m][0] * sc, v1 = acc[ai][bj][m][1] * sc;
                    if (seg == 2) {
#pragma unroll
                        for (int j = 0; j < 4; ++j) { v0[j] = v0[j] * sigm(v0[j]); v1[j] = v1[j] * sigm(v1[j]); } }
                    u32x4 w; w.x = cvt_pk_bf16(v0[0], v0[1]); w.y = cvt_pk_bf16(v0[2], v0[3]); w.z = cvt_pk_bf16(v1[0], v1[1]); w.w = cvt_pk_bf16(v1[2], v1[3]);
                    *(u32x4*)(rowp + bj * HALF) = w; } }
    }
};
}

#define LAS __attribute__((address_space(3)))
typedef pg8::bf16_t bf16_t;
typedef pg8::bf16x8 bf16x8;
typedef pg8::f32x4 f32x4;
typedef pg8::u32x4 u32x4;
typedef float f32x16 __attribute__((ext_vector_type(16)));
typedef float f32x2v __attribute__((ext_vector_type(2)));
typedef unsigned u32x2 __attribute__((ext_vector_type(2)));

constexpr int BATCH = 16, SEQ = 2048, DM = 1024, MTOK = BATCH * SEQ;
constexpr int NH = 8, CK = 31;
constexpr float EPS = 1e-6f;
constexpr float LOG2E = 1.4426950408889634f;
constexpr float LAM_INIT = 0.4707130183435842f;
constexpr int NTHREADS = 512, NWAVES = 8;
constexpr int NRF0 = 8;
constexpr int NRF = 4;
constexpr int LDS_BYTES = 163840;
constexpr size_t MiB = 1u << 20;
constexpr size_t WS_WT1 = 0, WS_WT2 = 6 * MiB, WS_WT3 = 8 * MiB, WS_WT3V = 14 * MiB, WS_WT4 = 16 * MiB;
constexpr size_t WS_RS0 = 22 * MiB;
constexpr size_t WS_RS = 21 * MiB;
constexpr size_t WS_CTL = 20 * MiB, CTL_BYTES = 16384;
constexpr size_t WS_A = 32 * MiB, WS_B = 96 * MiB, WS_C = 160 * MiB, WS_F = 224 * MiB, WS_G = 288 * MiB, WS_H = 352 * MiB, WS_END = 416 * MiB;

struct Args { const float* in[17]; float* out; unsigned char* ws; int ph_lo, ph_hi; };

__device__ __forceinline__ float wave_sum(float v) {
#pragma unroll
    for (int o = 1; o < 64; o <<= 1) v += __shfl_xor(v, o);
    return v;
}
typedef __bf16 bf16x2_t __attribute__((ext_vector_type(2)));
__device__ __forceinline__ unsigned pk2(float lo, float hi) { const f32x2v v = {lo, hi}; const bf16x2_t b = __builtin_convertvector(v, bf16x2_t); return __builtin_bit_cast(unsigned, b); }
__device__ __forceinline__ float bflo(unsigned u) { return __builtin_bit_cast(float, u << 16); }
__device__ __forceinline__ float bfhi(unsigned u) { return __builtin_bit_cast(float, u & 0xffff0000u); }
#define LDS_WAIT() asm volatile("s_waitcnt lgkmcnt(0)" ::: "memory")

__device__ __forceinline__ void transpose_item(const float* W, int ldw, int col0, const float* gain, bf16_t* WT, int dst_row0, LAS float* scr, int kb, int lane) {
    const int k0 = 64 * kb;
    float wv[32];
#pragma unroll
    for (int i = 0; i < 32; ++i) { const int kk = 2 * i + (lane >> 5); wv[i] = W[(size_t)(k0 + kk) * ldw + col0 + (lane & 31)]; }
#pragma unroll
    for (int i = 0; i < 32; ++i) { const int kk = 2 * i + (lane >> 5); const float gg = gain ? gain[k0 + kk] : 1.f; scr[kk * 33 + (lane & 31)] = wv[i] * gg; }
    LDS_WAIT();
    const int c = lane & 7;
#pragma unroll
    for (int j = 0; j < 4; ++j) { const int n = (lane >> 3) + 8 * j; const LAS float* s = scr + (8 * c) * 33 + n;
        u32x4 o; o.x = pk2(s[0 * 33], s[1 * 33]); o.y = pk2(s[2 * 33], s[3 * 33]); o.z = pk2(s[4 * 33], s[5 * 33]); o.w = pk2(s[6 * 33], s[7 * 33]);
        *(u32x4*)(WT + (size_t)(dst_row0 + n) * 1024 + k0 + 8 * c) = o; }
    LDS_WAIT();
}

__device__ __forceinline__ void rms_row_to_bf16(const float* xrow, bf16_t* orow, int lane) {
    const f32x4* xr = (const f32x4*)xrow + lane;
    f32x4 v[4]; float s = 0.f;
#pragma unroll
    for (int j = 0; j < 4; ++j) { v[j] = xr[64 * j]; s += (v[j].x * v[j].x + v[j].y * v[j].y) + (v[j].z * v[j].z + v[j].w * v[j].w); }
    const float r = rsqrtf(wave_sum(s) * (1.f / DM) + EPS);
    u32x2* o8 = (u32x2*)orow + lane;
#pragma unroll
    for (int j = 0; j < 4; ++j) { u32x2 w; w.x = pk2(v[j].x * r, v[j].y * r); w.y = pk2(v[j].z * r, v[j].w * r); o8[64 * j] = w; }
}

__device__ __forceinline__ void p0_phase(const Args& a, LAS unsigned char* lds, int lane, int wave) {
    LAS float* scr = (LAS float*)(lds + wave * 16384);
    constexpr int NWT = 2, NWR = NWAVES - NWT;
    unsigned char* ws = a.ws;
    const bool is_tw = wave >= NWR;
    const int gw = is_tw ? blockIdx.x * NWT + (wave - NWR) : blockIdx.x * NWR + wave, NGW = is_tw ? gridDim.x * NWT : gridDim.x * NWR;
    if (is_tw)
    for (int it = gw; it < 9 * 512; it += NGW) {
        const int piece = it >> 9, r = it & 511, kb = r >> 5, cb = (r & 31) * 32;
        switch (piece) {
        case 0: transpose_item(a.in[2], 3072, cb, a.in[1], (bf16_t*)(ws + WS_WT1), (cb >> 7) * 256 + (cb & 127), scr, kb, lane); break;
        case 1: transpose_item(a.in[2], 3072, 1024 + cb, a.in[1], (bf16_t*)(ws + WS_WT1), (cb >> 7) * 256 + 128 + (cb & 127), scr, kb, lane); break;
        case 2: transpose_item(a.in[2], 3072, 2048 + cb, a.in[1], (bf16_t*)(ws + WS_WT1), 2048 + cb, scr, kb, lane); break;
        case 3: transpose_item(a.in[7], 1024, cb, nullptr, (bf16_t*)(ws + WS_WT2), cb, scr, kb, lane); break;
        case 4: transpose_item(a.in[10], 2048, cb, a.in[9], (bf16_t*)(ws + WS_WT3), cb, scr, kb, lane); break;
        case 5: transpose_item(a.in[10], 2048, 1024 + cb, a.in[9], (bf16_t*)(ws + WS_WT3V), cb, scr, kb, lane); break;
        case 6: transpose_item(a.in[12], 2048, cb, a.in[11], (bf16_t*)(ws + WS_WT3), 1024 + cb, scr, kb, lane); break;
        case 7: transpose_item(a.in[12], 2048, 1024 + cb, a.in[11], (bf16_t*)(ws + WS_WT3), 2048 + cb, scr, kb, lane); break;
        default: transpose_item(a.in[15], 1024, cb, nullptr, (bf16_t*)(ws + WS_WT4), cb, scr, kb, lane); break;
        }
    }
    bf16_t* xn0 = (bf16_t*)(ws + WS_A);
    if (!is_tw)
    for (int m0 = gw; m0 < MTOK; m0 += NRF0 * NGW) {
        f32x4 v[NRF0][4];
#pragma unroll
        for (int rr = 0; rr < NRF0; ++rr) { const int m = m0 + rr * NGW; if (m < MTOK) { const f32x4* xr = (const f32x4*)(a.in[0] + (size_t)m * DM) + lane;
#pragma unroll
            for (int j = 0; j < 4; ++j) v[rr][j] = __builtin_nontemporal_load(xr + 64 * j); } }
#pragma unroll
        for (int rr = 0; rr < NRF0; ++rr) { const int m = m0 + rr * NGW; if (m < MTOK) { float sq = 0.f;
#pragma unroll
            for (int j = 0; j < 4; ++j) sq += (v[rr][j].x * v[rr][j].x + v[rr][j].y * v[rr][j].y) + (v[rr][j].z * v[rr][j].z + v[rr][j].w * v[rr][j].w);
            const float r = rsqrtf(wave_sum(sq) * (1.f / DM) + EPS);
            if (lane == 0) ((float*)(ws + WS_RS0))[m] = 1.f / r;
            u32x2* o8 = (u32x2*)(xn0 + (size_t)m * DM) + lane;
#pragma unroll
            for (int j = 0; j < 4; ++j) { u32x2 w; w.x = pk2(v[rr][j].x * r, v[rr][j].y * r); w.y = pk2(v[rr][j].z * r, v[rr][j].w * r); o8[64 * j] = w; } } }
    }
}

#define RS_STEP(N, MASK) { const bool up_ = (lane & (MASK)) != 0; _Pragma("unroll") for (int i_ = 0; i_ < (N) / 2; ++i_) { \
        const float keep_ = up_ ? rv[i_ + (N) / 2] : rv[i_], send_ = up_ ? rv[i_] : rv[i_ + (N) / 2]; rv[i_] = keep_ + __shfl_xor(send_, (MASK)); } }
__device__ __forceinline__ void conv_phase(LAS unsigned char* lds, const bf16_t* g, const bf16_t* sz, bf16_t* cgo,
                                           const float* wdw, const float* bdw, const float* lng, const float* lnb) {
    const int tid = threadIdx.x, lane = tid & 63, wave = tid >> 6;
    LAS float* red = (LAS float*)(lds + 131072);
    LAS float* stat = red + 128;
    f32x2v w[CK];
#pragma unroll
    for (int k = 0; k < CK; ++k) w[k] = *(const f32x2v*)(wdw + k * 1024 + 2 * tid);
    const f32x2v bb = *(const f32x2v*)(bdw + 2 * tid), lg = *(const f32x2v*)(lng + 2 * tid), lb = *(const f32x2v*)(lnb + 2 * tid);
    for (int chunk = blockIdx.x; chunk < MTOK / 128; chunk += gridDim.x) {
        const int c0 = chunk * 128, s0 = c0 & (SEQ - 1);
        __syncthreads();
        for (int id = tid; id < 62 * 128; id += NTHREADS) { const int row = id >> 7, ch = id & 127;
            u32x4 v = {0u, 0u, 0u, 0u};
            if (s0 - 30 + row >= 0) v = *(const u32x4*)(g + (size_t)(c0 - 30 + row) * 1024 + ch * 8);
            *(LAS u32x4*)(lds + row * 2048 + ch * 16) = v; }
        __syncthreads();
#pragma unroll 1
        for (int tile = 0; tile < 4; ++tile) {
            u32x4 pf[8];
            if (tile < 3) {
#pragma unroll
                for (int i = 0; i < 8; ++i) { const int id = tid + NTHREADS * i; pf[i] = __builtin_nontemporal_load((const u32x4*)(g + (size_t)(c0 + 32 + 32 * tile + (id >> 7)) * 1024 + (id & 127) * 8)); } }
#pragma unroll 1
            for (int gq = 0; gq < 4; ++gq) {
                const int rbase = (32 * tile + 8 * gq) & 63;
                f32x2v v[38];
#pragma unroll
                for (int i = 0; i < 38; ++i) { const int slot = (rbase + i) & 63; const unsigned u = *(const LAS unsigned*)(lds + slot * 2048 + tid * 4); v[i] = (f32x2v){bflo(u), bfhi(u)}; }
                unsigned zz[8];
#pragma unroll
                for (int tt = 0; tt < 8; ++tt) zz[tt] = *(const unsigned*)(sz + (size_t)(c0 + 32 * tile + gq * 8 + tt) * 1024 + 2 * tid);
                f32x2v cv[8];
#pragma unroll
                for (int tt = 0; tt < 8; ++tt) { f32x2v acc = bb;
#pragma unroll
                    for (int k = 0; k < CK; ++k) acc = __builtin_elementwise_fma(w[k], v[tt + k], acc);
                    cv[tt] = acc; }
                float rv[16];
#pragma unroll
                for (int tt = 0; tt < 8; ++tt) { rv[2 * tt] = cv[tt].x + cv[tt].y; rv[2 * tt + 1] = cv[tt].x * cv[tt].x + cv[tt].y * cv[tt].y; }
                RS_STEP(16, 32) RS_STEP(8, 16) RS_STEP(4, 8) RS_STEP(2, 4)
                rv[0] += __shfl_xor(rv[0], 2); rv[0] += __shfl_xor(rv[0], 1);
                if ((lane & 3) == 0) red[wave * 16 + (lane >> 2)] = rv[0];
                __syncthreads();
                if (tid < 8) { float s = 0.f, q = 0.f;
#pragma unroll
                    for (int ww = 0; ww < 8; ++ww) { s += red[ww * 16 + 2 * tid]; q += red[ww * 16 + 2 * tid + 1]; }
                    const float mu = s * (1.f / 1024.f), var = fmaxf(q * (1.f / 1024.f) - mu * mu, 0.f);
                    stat[2 * tid] = mu; stat[2 * tid + 1] = rsqrtf(var + EPS); }
                __syncthreads();
#pragma unroll
                for (int tt = 0; tt < 8; ++tt) { const float mu = stat[2 * tt], rs = stat[2 * tt + 1];
                    float n0 = (cv[tt].x - mu) * rs * lg.x + lb.x, n1 = (cv[tt].y - mu) * rs * lg.y + lb.y;
                    n0 = n0 * pg8::sigm(n0) * bflo(zz[tt]); n1 = n1 * pg8::sigm(n1) * bfhi(zz[tt]);
                    *(unsigned*)(cgo + (size_t)(c0 + 32 * tile + gq * 8 + tt) * 1024 + 2 * tid) = pk2(n0, n1); }
            }
            if (tile < 3) {
#pragma unroll
                for (int i = 0; i < 8; ++i) { const int id = tid + NTHREADS * i; const int slot = (62 + 32 * tile + (id >> 7)) & 63;
                    *(LAS u32x4*)(lds + slot * 2048 + (id & 127) * 16) = pf[i]; }
                __syncthreads();
            }
        }
    }
}

constexpr int NRP = 4;
struct RowGroup { u32x2 x[NRP][4], y[NRP][4]; float rsc[NRP]; };
__device__ __forceinline__ void rows_load(RowGroup& g, const bf16_t* xinb, const float* rs_in, const bf16_t* y, int m0, int NGW, int lane) {
#pragma unroll
    for (int rr = 0; rr < NRP; ++rr) { const int m = m0 + rr * NGW; if (m < MTOK) {
        const u32x2* xr = (const u32x2*)(xinb + (size_t)m * DM) + lane; const u32x2* yr = (const u32x2*)(y + (size_t)m * DM) + lane; g.rsc[rr] = rs_in[m];
#pragma unroll
        for (int j = 0; j < 4; ++j) { g.x[rr][j] = __builtin_nontemporal_load(xr + 64 * j); g.y[rr][j] = __builtin_nontemporal_load(yr + 64 * j); } } }
}
template <bool FIRST>
__device__ __forceinline__ void rows_finish(const RowGroup& g, const f32x4 (&gp)[4], float* xout, float* rs_out, bf16_t* xn, int m0, int NGW, int lane) {
#pragma unroll
    for (int rr = 0; rr < NRP; ++rr) { const int m = m0 + rr * NGW; if (m < MTOK) {
        f32x4 xv[4], yv[4]; float s = 0.f;
#pragma unroll
        for (int j = 0; j < 4; ++j) { const u32x2 u = g.x[rr][j], w = g.y[rr][j];
            xv[j] = (f32x4){bflo(u.x), bfhi(u.x), bflo(u.y), bfhi(u.y)} * g.rsc[rr]; yv[j] = (f32x4){bflo(w.x), bfhi(w.x), bflo(w.y), bfhi(w.y)};
            s += (yv[j].x * yv[j].x + yv[j].y * yv[j].y) + (yv[j].z * yv[j].z + yv[j].w * yv[j].w); }
        const float r = rsqrtf(wave_sum(s) * (1.f / DM) + EPS);
        float s1 = 0.f;
#pragma unroll
        for (int j = 0; j < 4; ++j) { xv[j] = xv[j] + yv[j] * r * gp[j];
            s1 += (xv[j].x * xv[j].x + xv[j].y * xv[j].y) + (xv[j].z * xv[j].z + xv[j].w * xv[j].w); }
        if (FIRST) {
            const float r1 = rsqrtf(wave_sum(s1) * (1.f / DM) + EPS);
            u32x2* o8 = (u32x2*)(xn + (size_t)m * DM) + lane;
            if (lane == 0) rs_out[m] = 1.f / r1;
#pragma unroll
            for (int j = 0; j < 4; ++j) { u32x2 w; w.x = pk2(xv[j].x * r1, xv[j].y * r1); w.y = pk2(xv[j].z * r1, xv[j].w * r1); o8[64 * j] = w; }
        } else {
            f32x4* xo = (f32x4*)(xout + (size_t)m * DM) + lane;
#pragma unroll
            for (int j = 0; j < 4; ++j) __builtin_nontemporal_store(xv[j], xo + 64 * j);
        } } }
}
template <bool FIRST>
__device__ __forceinline__ void resid_phase(const bf16_t* xinb, const float* rs_in, const bf16_t* y, const float* gpost, float* xout, float* rs_out, bf16_t* xn, int lane, int wave) {
    const int gw = blockIdx.x * NWAVES + wave, NGW = gridDim.x * NWAVES, step = NRP * NGW;
    f32x4 gp[4];
#pragma unroll
    for (int j = 0; j < 4; ++j) gp[j] = ((const f32x4*)gpost)[lane + 64 * j];
    RowGroup ga, gb;
    rows_load(ga, xinb, rs_in, y, gw, NGW, lane);
#pragma unroll 1
    for (int m0 = gw; m0 < MTOK; m0 += 2 * step) {
        rows_load(gb, xinb, rs_in, y, m0 + step, NGW, lane);
        rows_finish<FIRST>(ga, gp, xout, rs_out, xn, m0, NGW, lane);
        rows_load(ga, xinb, rs_in, y, m0 + 2 * step, NGW, lane);
        rows_finish<FIRST>(gb, gp, xout, rs_out, xn, m0 + step, NGW, lane);
    }
}
#define XB_TMO      128
#define XB_XCNT(j)  (256  + 64 * (j))
#define XB_XSUB(j)  (1280 + 64 * (j))
#define XB_XGEN(j)  (2304 + 64 * (j))
#define XB_TOP      3328
#define XB_TOPGEN   3392
#define XCD_BAR_WORDS 3456
#define XB_SPIN_CAP (1u << 18)

__device__ __forceinline__ unsigned xb_ld(unsigned* p)              { return __hip_atomic_load(p, __ATOMIC_RELAXED, __HIP_MEMORY_SCOPE_AGENT); }
__device__ __forceinline__ unsigned xb_add(unsigned* p, unsigned v) { return __hip_atomic_fetch_add(p, v, __ATOMIC_RELAXED, __HIP_MEMORY_SCOPE_AGENT); }
__device__ __forceinline__ unsigned xb_xcc_id() { return (unsigned)__builtin_amdgcn_s_getreg((3 << 11) | 20) & 0xFu; }
#define XB_SPIN(cond, bar) do { unsigned _sp = 0; while (cond) { __builtin_amdgcn_s_sleep(1); \
    if ((++_sp & 255u) == 0u) { if (xb_ld(&(bar)[XB_TMO])) break; if (_sp > XB_SPIN_CAP) { atomicAdd(&(bar)[XB_TMO], 1u); break; } } } } while (0)

struct XcdBarrier {
    unsigned* bar; unsigned x, nloc, nx;
};

__device__ __forceinline__ void xcd_barrier_complete(unsigned* bar, unsigned x, unsigned& nloc, unsigned& nx) {
    const unsigned G = gridDim.x * gridDim.y * gridDim.z;
    unsigned sum, cnt, mine, sp = 0u;
    for (;;) {
        sum = 0u; cnt = 0u; mine = 0u;
#pragma unroll
        for (unsigned j = 0; j < 16; ++j) { const unsigned c = xb_ld(&bar[XB_XCNT(j)]); sum += c; cnt += (c > 0u) ? 1u : 0u; mine = (j == x) ? c : mine; }
        if (sum == G) break;
        __builtin_amdgcn_s_sleep(1);
        if ((++sp & 255u) == 0u) { if (xb_ld(&bar[XB_TMO])) break; if (sp > XB_SPIN_CAP) { atomicAdd(&bar[XB_TMO], 1u); break; } }
    }
    nloc = mine > 0u ? mine : 1u; nx = cnt > 0u ? cnt : 1u;
}

__device__ __forceinline__ void xcd_barrier(const XcdBarrier& b) {
    asm volatile("s_waitcnt vmcnt(0)" ::: "memory");
    __syncthreads();
    if (threadIdx.x == 0) {
        unsigned* bar = b.bar;
        __builtin_amdgcn_s_waitcnt(0);
        const unsigned nloc = b.nloc, nx = b.nx;
        const unsigned old = xb_add(&bar[XB_XSUB(b.x)], 1u);
        const unsigned gen = old / nloc;
        if (old + 1u == (gen + 1u) * nloc) {
            __builtin_amdgcn_fence(__ATOMIC_RELEASE, "agent");
            asm volatile("s_waitcnt vmcnt(0)" ::: "memory");
            const unsigned og = xb_add(&bar[XB_TOP], 1u);
            const unsigned tg = og / nx;
            if (og + 1u == (tg + 1u) * nx) xb_add(&bar[XB_TOPGEN], 1u);
            else XB_SPIN(xb_ld(&bar[XB_TOPGEN]) == tg, bar);
            __builtin_amdgcn_fence(__ATOMIC_ACQUIRE, "agent");
            xb_add(&bar[XB_XGEN(b.x)], 1u);
            asm volatile("s_waitcnt vmcnt(0)" ::: "memory");
        } else {
            XB_SPIN(xb_ld(&bar[XB_XGEN(b.x)]) == gen, bar);
            __builtin_amdgcn_fence(__ATOMIC_ACQUIRE, "agent");
            asm volatile("s_waitcnt vmcnt(0)" ::: "memory");
        }
    }
    __syncthreads();
}
__device__ __forceinline__ XcdBarrier xcd_barrier_init(unsigned* bar, volatile LAS unsigned* tmp) {
    XcdBarrier b; b.bar = bar; b.x = xb_xcc_id();
    if (threadIdx.x == 0) { (void)xb_add(&bar[XB_XCNT(b.x)], 1u); unsigned nloc, nx; xcd_barrier_complete(bar, b.x, nloc, nx); tmp[0] = nloc; tmp[1] = nx; }
    __syncthreads();
    b.nloc = (unsigned)__builtin_amdgcn_readfirstlane((int)tmp[0]); b.nx = (unsigned)__builtin_amdgcn_readfirstlane((int)tmp[1]);
    __syncthreads();
    return b;
}


constexpr int KT_BYTES = 64 * 256, VT_BYTES = 128 * 128, NBUF = 3, LDS_VOFF = NBUF * KT_BYTES, LDS_QOFF = NBUF * (KT_BYTES + VT_BYTES);
typedef short v4i16_t __attribute__((ext_vector_type(4)));
__device__ __forceinline__ v4i16_t vtr16(const LAS unsigned char* p) { return __builtin_amdgcn_ds_read_tr16_b64_v4i16((LAS v4i16_t*)p); }
__device__ __forceinline__ int pi32(int i) { return (i & ~12) | ((i & 4) << 1) | ((i & 8) >> 1); }
__device__ __forceinline__ float hmax32(float v) { auto rr = __builtin_amdgcn_permlane32_swap(__float_as_uint(v), __float_as_uint(v), false, false); return fmaxf(__uint_as_float(rr[0]), __uint_as_float(rr[1])); }
__device__ __forceinline__ float hsum32(float v) { auto rr = __builtin_amdgcn_permlane32_swap(__float_as_uint(v), __float_as_uint(v), false, false); return __uint_as_float(rr[0]) + __uint_as_float(rr[1]); }

template <bool DIAG>
__device__ __forceinline__ void attn_sub(f32x16 (&O)[2][4], const LAS unsigned char* qlds, float (&mrun)[2], float (&lrun)[2],
                                         const LAS unsigned char* const (&kptr)[2][4], const LAS unsigned char* const (&vptr)[4][2], int koff, int voff, const f32x16& cinit, float cb, int j32, int hi, bool isdiag) {
    f32x16 x0, x1;
#pragma unroll
    for (int sh = 0; sh < 2; ++sh) {
        bf16x8 kf[2][2], qv[2][2];
#pragma unroll
        for (int c = 0; c < 2; ++c)
#pragma unroll
            for (int s2 = 0; s2 < 2; ++s2) { kf[c][s2] = *(const LAS bf16x8*)(kptr[c][sh * 2 + s2] + koff); qv[c][s2] = *(const LAS bf16x8*)(qlds + (c * 4 + sh * 2 + s2) * 1024); }
        if (sh == 0) {
            x0 = __builtin_amdgcn_mfma_f32_32x32x16_bf16(kf[0][0], qv[0][0], cinit, 0, 0, 0); x1 = __builtin_amdgcn_mfma_f32_32x32x16_bf16(kf[1][0], qv[1][0], cinit, 0, 0, 0);
            x0 = __builtin_amdgcn_mfma_f32_32x32x16_bf16(kf[0][1], qv[0][1], x0, 0, 0, 0); x1 = __builtin_amdgcn_mfma_f32_32x32x16_bf16(kf[1][1], qv[1][1], x1, 0, 0, 0);
        } else {
#pragma unroll
            for (int s2 = 0; s2 < 2; ++s2) { x0 = __builtin_amdgcn_mfma_f32_32x32x16_bf16(kf[0][s2], qv[0][s2], x0, 0, 0, 0); x1 = __builtin_amdgcn_mfma_f32_32x32x16_bf16(kf[1][s2], qv[1][s2], x1, 0, 0, 0); }
        }
        __builtin_amdgcn_sched_barrier(0);
    }
    if (isdiag) {
#pragma unroll
        for (int r = 0; r < 16; ++r) { const int kk = 16 * (r >> 3) + 8 * hi + (r & 7); if (kk > j32) { x0[r] = -INFINITY; x1[r] = -INFINITY; } } }
    float mx0 = fmaxf(x0[0], x0[1]), mx1 = fmaxf(x1[0], x1[1]);
#pragma unroll
    for (int r = 2; r < 16; r += 2) { mx0 = fmaxf(fmaxf(mx0, x0[r]), x0[r + 1]); mx1 = fmaxf(fmaxf(mx1, x1[r]), x1[r + 1]); }
    const float mc0 = hmax32(mx0) + cb, mc1 = hmax32(mx1) + cb;
    if (__any((mc0 > mrun[0] + 8.f) || (mc1 > mrun[1] + 8.f))) {
        const float mn0 = fmaxf(mrun[0], mc0), al0 = __builtin_amdgcn_exp2f(mrun[0] - mn0), mn1 = fmaxf(mrun[1], mc1), al1 = __builtin_amdgcn_exp2f(mrun[1] - mn1);
        lrun[0] *= al0; lrun[1] *= al1; mrun[0] = mn0; mrun[1] = mn1;
#pragma unroll
        for (int dt = 0; dt < 4; ++dt)
#pragma unroll
            for (int r = 0; r < 16; ++r) { O[0][dt][r] *= al0; O[1][dt][r] *= al1; }
    }
    const float off0 = cb - mrun[0], off1 = cb - mrun[1];
    float ls0 = 0.f, ls1 = 0.f;
#pragma unroll
    for (int r = 0; r < 16; ++r) { x0[r] = __builtin_amdgcn_exp2f(x0[r] + off0); ls0 += x0[r]; x1[r] = __builtin_amdgcn_exp2f(x1[r] + off1); ls1 += x1[r]; }
    lrun[0] += ls0; lrun[1] += ls1;
    bf16x8 p0[2], p1[2];
#pragma unroll
    for (int t = 0; t < 2; ++t) {
        p0[t] = __builtin_bit_cast(bf16x8, (u32x4){pk2(x0[8 * t], x0[8 * t + 1]), pk2(x0[8 * t + 2], x0[8 * t + 3]), pk2(x0[8 * t + 4], x0[8 * t + 5]), pk2(x0[8 * t + 6], x0[8 * t + 7])});
        p1[t] = __builtin_bit_cast(bf16x8, (u32x4){pk2(x1[8 * t], x1[8 * t + 1]), pk2(x1[8 * t + 2], x1[8 * t + 3]), pk2(x1[8 * t + 4], x1[8 * t + 5]), pk2(x1[8 * t + 6], x1[8 * t + 7])}); }
#pragma unroll
    for (int dt = 0; dt < 4; ++dt) {
        bf16x8 vf[2];
#pragma unroll
        for (int t = 0; t < 2; ++t) { const v4i16_t lo_ = vtr16(vptr[dt][0] + voff + t * 4096), hi_ = vtr16(vptr[dt][1] + voff + t * 4096);
            vf[t] = (bf16x8){lo_[0], lo_[1], lo_[2], lo_[3], hi_[0], hi_[1], hi_[2], hi_[3]}; }
#pragma unroll
        for (int t = 0; t < 2; ++t) {
            O[0][dt] = __builtin_amdgcn_mfma_f32_32x32x16_bf16(vf[t], p0[t], O[0][dt], 0, 0, 0);
            O[1][dt] = __builtin_amdgcn_mfma_f32_32x32x16_bf16(vf[t], p1[t], O[1][dt], 0, 0, 0); }
    }
}

__device__ __forceinline__ void attn_unit(LAS unsigned char* lds, int b, int h, int qb, const bf16_t* Qb, const bf16_t* Kb, const bf16_t* VT, const bf16_t* Zs, bf16_t* og,
                                          const float* gsub, float lam) {
    const int tid = threadIdx.x, lane = tid & 63, j32 = lane & 31, hi = lane >> 5; const int wid = __builtin_amdgcn_readfirstlane(tid >> 6);
    const float sl2 = exp2f(-(float)(h + 1)) * LOG2E;
    const size_t tokbase = (size_t)b * SEQ;
    const int q0w = qb * 256 + wid * 32, qpos = q0w + j32;
    LAS unsigned char* qlds = lds + LDS_QOFF + wid * 8192 + lane * 16;
    { const bf16_t* qp = Qb + (tokbase + qpos) * 1024 + h * 128 + hi * 8;
#pragma unroll
      for (int c = 0; c < 2; ++c)
#pragma unroll
          for (int s = 0; s < 4; ++s) *(LAS bf16x8*)(qlds + (c * 4 + s) * 1024) = *(const bf16x8*)(qp + c * 64 + s * 16); }
    f32x16 O[2][4];
#pragma unroll
    for (int c = 0; c < 2; ++c)
#pragma unroll
        for (int dt = 0; dt < 4; ++dt)
#pragma unroll
            for (int r = 0; r < 16; ++r) O[c][dt][r] = 0.f;
    float mrun[2] = {-1e30f, -1e30f}, lrun[2] = {0.f, 0.f};
    f32x16 cinit;
    { int hio = hi; asm volatile("" : "+v"(hio));
#pragma unroll
      for (int r = 0; r < 16; ++r) cinit[r] = sl2 * (float)(16 * (r >> 3) + 8 * hio + (r & 7)); }
    const int nsub_w = qb * 8 + wid + 1, NT = 4 * qb + 4;
    const bf16_t* Kbh = Kb + tokbase * 1024 + h * 128;
    const bf16_t* Vbh = VT + tokbase * 1024 + h * 128;
    unsigned kgo[2], vgo[2];
#pragma unroll
    for (int i = 0; i < 2; ++i) { const int kr = 4 * (2 * wid + i) + (lane >> 4), vr = 8 * (2 * wid + i) + (lane >> 3);
        kgo[i] = (unsigned)(kr * 1024 + (((lane & 15) ^ (kr & 15)) * 8)) * 2u;
        vgo[i] = (unsigned)(kr * 1024 + (((lane & 15) ^ (((kr & 3) << 2) | ((kr >> 2) & 3))) * 8)) * 2u; (void)vr; }
#define DMAT(kt, bf) do { const char* kb_ = (const char*)Kbh + (size_t)(unsigned)__builtin_amdgcn_readfirstlane((kt) * 131072); \
        const char* vb_ = (const char*)Vbh + (size_t)(unsigned)__builtin_amdgcn_readfirstlane((kt) * 131072); \
        _Pragma("unroll") for (int i_ = 0; i_ < 2; ++i_) { \
        __builtin_amdgcn_global_load_lds((const unsigned*)(kb_ + kgo[i_]), (LAS unsigned*)(lds + (bf) * KT_BYTES + (2 * wid + i_) * 1024), 16, 0, 0); \
        __builtin_amdgcn_global_load_lds((const unsigned*)(vb_ + vgo[i_]), (LAS unsigned*)(lds + LDS_VOFF + (bf) * VT_BYTES + (2 * wid + i_) * 1024), 16, 0, 0); } } while (0)
    const int krow = pi32(j32);
    const int kbase = krow * 256 + (((krow & 15) ^ hi) << 4);
    const int vbase = j32 * 128 + ((((j32 >> 1) & 7) ^ hi) << 4);
    const LAS unsigned char* kptr[2][4]; const LAS unsigned char* vptr[4][2];
#pragma unroll
    for (int c = 0; c < 2; ++c)
#pragma unroll
        for (int s_ = 0; s_ < 4; ++s_) kptr[c][s_] = lds + (kbase ^ ((c * 8 + s_ * 2) << 4));
    {
      const int q_ = (lane >> 2) & 3, p_ = lane & 3, g_ = (lane >> 4) & 1;
#pragma unroll
      for (int dt = 0; dt < 4; ++dt)
#pragma unroll
          for (int h4 = 0; h4 < 2; ++h4) { const int row_ = 8 * hi + 4 * h4 + q_, f_ = (q_ << 2) | ((2 * hi + h4) & 3), ch_ = dt * 4 + g_ * 2 + (p_ >> 1);
              vptr[dt][h4] = lds + LDS_VOFF + 256 * row_ + 16 * (ch_ ^ f_) + 8 * (p_ & 1); } }
#define WAIT_BAR(N) asm volatile("s_waitcnt vmcnt(" #N ") lgkmcnt(0)\n\ts_barrier" ::: "memory")
    asm volatile("s_waitcnt vmcnt(0)" ::: "memory");
    DMAT(NT - 1, 0); DMAT(NT - 2, 1);
#pragma unroll 1
    for (int it0 = 0; it0 < NT; it0 += NBUF) {
#pragma unroll
        for (int buf = 0; buf < NBUF; ++buf) {
            const int it = it0 + buf;
            if (it < NT) {
                const int kt = NT - 1 - it;
                if (it + 1 < NT) WAIT_BAR(4); else WAIT_BAR(0);
                if (it + 2 < NT) DMAT(kt - 2, (buf + 2) % NBUF);
#pragma unroll
                for (int st = 1; st >= 0; --st) {
                    const int sub = 2 * kt + st;
                    if (sub < nsub_w) {
                        const float cb = sl2 * (float)(sub * 32 - qpos);
                        attn_sub<true>(O, qlds, mrun, lrun, kptr, vptr, buf * KT_BYTES + st * 8192, buf * VT_BYTES + st * 8192, cinit, cb, j32, hi, sub == nsub_w - 1);
                    }
                }
            }
        }
    }
    asm volatile("s_waitcnt lgkmcnt(0)\n\ts_barrier" ::: "memory");
#undef WAIT_BAR
#undef DMAT
    const float inv0 = 1.f / hsum32(lrun[0]), k1 = -lam / hsum32(lrun[1]);
    float ss = 0.f;
#pragma unroll
    for (int dt = 0; dt < 4; ++dt)
#pragma unroll
        for (int r = 0; r < 16; ++r) { const float o = O[0][dt][r] * inv0 + O[1][dt][r] * k1; O[0][dt][r] = o; ss += o * o; }
    const float rs = rsqrtf(hsum32(ss) * (1.f / 128.f) + EPS) * (1.f - LAM_INIT);
    int hie = hi, qpe = qpos; asm volatile("" : "+v"(hie), "+v"(qpe));
    const size_t orow = (tokbase + qpe) * 1024 + h * 128;
#pragma unroll
    for (int dt = 0; dt < 4; ++dt)
#pragma unroll
        for (int rq = 0; rq < 4; ++rq) { const int dv = 32 * dt + 8 * rq + 4 * hie;
            const f32x4 gs = *(const f32x4*)(gsub + dv); const u32x2 zz = *(const u32x2*)(Zs + orow + dv);
            u32x2 w; w.x = pk2(O[0][dt][4 * rq] * rs * gs.x * bflo(zz.x), O[0][dt][4 * rq + 1] * rs * gs.y * bfhi(zz.x));
            w.y = pk2(O[0][dt][4 * rq + 2] * rs * gs.z * bflo(zz.y), O[0][dt][4 * rq + 3] * rs * gs.w * bfhi(zz.y));
            *(u32x2*)(og + orow + dv) = w; }
}

__device__ __forceinline__ void attn_phase(LAS unsigned char* lds, const bf16_t* Qb, const bf16_t* Kb, const bf16_t* VT, const bf16_t* Zs, bf16_t* og, const float* gsub, float lam) {
    for (int vb = blockIdx.x; vb < 256; vb += gridDim.x) {
        const int bh = vb & 127, half = vb >> 7;
#pragma unroll 1
        for (int ui = 0; ui < 4; ++ui) {
            const int qb = half == 0 ? (ui == 0 ? 7 : ui == 1 ? 0 : ui == 2 ? 5 : 2) : (ui == 0 ? 6 : ui == 1 ? 1 : ui == 2 ? 4 : 3);
            attn_unit(lds, bh >> 3, bh & 7, qb, Qb, Kb, VT, Zs, og, gsub, lam);
        }
    }
}

#ifndef REP_PH
#define REP_PH -1
#endif
#ifndef REP_N
#define REP_N 1
#endif
#define NREP(k) ((k) == REP_PH ? REP_N : 1)
#ifndef N_CG_SYNC
#define N_CG_SYNC 0
#endif
#ifndef MK_MULTI
#define MK_MULTI 0
#endif
__global__ void __launch_bounds__(NTHREADS, 2) yoco_fwd(Args a) {
    extern __shared__ __attribute__((aligned(16))) unsigned char lds_raw[];
    LAS unsigned char* lds = (LAS unsigned char*)lds_raw;
    cg::grid_group grid = cg::this_grid();
    const int tid = threadIdx.x, lane = tid & 63, wave = __builtin_amdgcn_readfirstlane(tid >> 6);
    const int lo = a.ph_lo, hi = a.ph_hi;
    const XcdBarrier xbar = xcd_barrier_init((unsigned*)(a.ws + WS_CTL), (volatile LAS unsigned*)lds);
    unsigned char* ws = a.ws;
    bf16_t* SA = (bf16_t*)(ws + WS_A); bf16_t* SB = (bf16_t*)(ws + WS_B); bf16_t* SC = (bf16_t*)(ws + WS_C); bf16_t* SF = (bf16_t*)(ws + WS_F); bf16_t* SG = (bf16_t*)(ws + WS_G); bf16_t* SH = (bf16_t*)(ws + WS_H);
#define IN(k) (lo <= (k) && (k) < hi)
#define SEAM(k) do { if (IN(k) && IN((k) + 1)) { if ((k) < N_CG_SYNC) grid.sync(); else xcd_barrier(xbar); } } while (0)
    if (lo > hi) grid.sync();
    if (IN(0)) { for (int rep = 0; rep < NREP(0); ++rep) p0_phase(a, lds, lane, wave); }
    SEAM(0);
    if (IN(1)) {
        pg8::Gemm g{SA, (const bf16_t*)(ws + WS_WT1), MTOK, 3072, 1024}; pg8::StaticOrder S; S.init(MTOK, 3072, gridDim.x, blockIdx.x); S.rep = NREP(1);
        pg8::EpiGlu E{SB, SC};
        pg8::gemm_phase<pg8::EpiGlu, pg8::StaticOrder, true, true>(lds, g, S, E);
    }
    SEAM(1);
    if (IN(2)) { for (int rep = 0; rep < NREP(2); ++rep) conv_phase(lds, SB, SC, SH, a.in[3], a.in[4], a.in[5], a.in[6]); }
    SEAM(2);
    if (IN(3)) {
        pg8::Gemm g{SH, (const bf16_t*)(ws + WS_WT2), MTOK, 1024, 1024}; pg8::StaticOrder S; S.init(MTOK, 1024, gridDim.x, blockIdx.x); S.rep = NREP(3);
        pg8::EpiPlain E{SB, 1024, 1.f};
        pg8::gemm_phase<pg8::EpiPlain, pg8::StaticOrder, true, true>(lds, g, S, E);
    }
    SEAM(3);
    if (IN(4)) { for (int rep = 0; rep < NREP(4); ++rep) resid_phase<true>(SA, (const float*)(ws + WS_RS0), SB, a.in[8], nullptr, (float*)(ws + WS_RS), SH, lane, wave); }
    SEAM(4);
    if (IN(5)) {
        {
            static_assert(WS_WT3V == WS_WT3 + (size_t)3072 * 1024 * 2 && WS_G - WS_F == WS_C - WS_B, "K|Q|Z|V weights contiguous, output slots equally spaced");
            pg8::Gemm g{SH, (const bf16_t*)(ws + WS_WT3), MTOK, 4096, 1024}; pg8::StaticOrder S; S.init(MTOK, 4096, gridDim.x, blockIdx.x); S.rep = NREP(5);
            pg8::EpiKQZ E{SB, (size_t)(WS_C - WS_B) / 2, 0.125f * LOG2E};   static_assert(WS_C - WS_B == WS_F - WS_C, "K|Q|Z slots equally spaced");
            pg8::gemm_phase<pg8::EpiKQZ, pg8::StaticOrder, true, true>(lds, g, S, E);
        }
    }
    SEAM(5);
    if (IN(6)) {
        const float* lp = a.in[13];
        const float sa = wave_sum(lp[lane] * lp[64 + lane]), sb = wave_sum(lp[128 + lane] * lp[192 + lane]);
        const float lam = expf(sa) - expf(sb) + LAM_INIT;
        for (int rep = 0; rep < NREP(6); ++rep) attn_phase(lds, SC, SB, SG, SF, SA, a.in[14], lam);
    }
    SEAM(6);
    if (IN(7)) {
        pg8::Gemm g{SA, (const bf16_t*)(ws + WS_WT4), MTOK, 1024, 1024}; pg8::StaticOrder S; S.init(MTOK, 1024, gridDim.x, blockIdx.x);
        pg8::EpiPlain E{SB, 1024, 1.f};
        pg8::gemm_phase<pg8::EpiPlain, pg8::StaticOrder, true, true>(lds, g, S, E);
    }
    SEAM(7);
    if (IN(8)) { resid_phase<false>(SH, (const float*)(ws + WS_RS), SB, a.in[16], a.out, nullptr, nullptr, lane, wave); }
#undef IN
#undef SEAM
}

extern "C" void kernel_launch(void* const* d_in, const int* in_sizes, int n_in, void* d_out, int out_size, void* d_ws, size_t ws_size, hipStream_t stream) {
    static int grid = 0;
    if (grid == 0) {
        if (n_in != 17 || in_sizes[0] != MTOK * DM || out_size != MTOK * DM || ws_size < WS_END) {
            fprintf(stderr, "kernel_launch: unexpected shapes (n_in %d in0 %d out %d ws %zu)\n", n_in, n_in > 0 ? in_sizes[0] : -1, out_size, ws_size); grid = -1; return; }
        int dev = 0, cus = 0, per_cu = 0;
        hipGetDevice(&dev);
        hipDeviceGetAttribute(&cus, hipDeviceAttributeMultiprocessorCount, dev);
        if (hipFuncSetAttribute((const void*)yoco_fwd, hipFuncAttributeMaxDynamicSharedMemorySize, LDS_BYTES) != hipSuccess) fprintf(stderr, "kernel_launch: hipFuncSetAttribute failed\n");
        if (hipOccupancyMaxActiveBlocksPerMultiprocessor(&per_cu, (const void*)yoco_fwd, NTHREADS, LDS_BYTES) != hipSuccess || per_cu < 1) {
            fprintf(stderr, "kernel_launch: occupancy query says %d blocks/CU\n", per_cu); per_cu = 1; }
        (void)hipGetLastError();
        grid = cus * per_cu; if (grid > 256) grid = 256;
        fprintf(stderr, "kernel_launch: grid %d (cus %d, per_cu %d)\n", grid, cus, per_cu);
    }
    if (grid < 0) return;
    if (hipMemsetAsync((char*)d_ws + WS_CTL, 0, CTL_BYTES, stream) != hipSuccess) fprintf(stderr, "kernel_launch: memset of the barrier words failed\n");
    Args a{};
    for (int i = 0; i < 17; ++i) a.in[i] = (const float*)d_in[i];
    a.out = (float*)d_out; a.ws = (unsigned char*)d_ws;
#if MK_MULTI
    for (int p = 0; p < 9; ++p) { a.ph_lo = p; a.ph_hi = p + 1; hipLaunchKernelGGL(yoco_fwd, dim3(grid), dim3(NTHREADS), LDS_BYTES, stream, a); }
#else
    a.ph_lo = 0; a.ph_hi = 9;
    void* args[] = {&a};
    hipError_t e = hipLaunchCooperativeKernel((const void*)yoco_fwd, dim3(grid), dim3(NTHREADS), args, LDS_BYTES, stream);
    if (e != hipSuccess) fprintf(stderr, "cooperative launch failed: %s (grid %d)\n", hipGetErrorString(e), grid);
#endif
}
```

```cpp
#include <hip/hip_runtime.h>
#include <hip/hip_cooperative_groups.h>
#include <cstdio>
#include <cstdint>
namespace cg = cooperative_groups;
namespace pg8 {
#define PG8_LAS __attribute__((address_space(3)))
typedef unsigned short bf16_t;
typedef short bf16x8 __attribute__((ext_vector_type(8)));
typedef float f32x4 __attribute__((ext_vector_type(4)));
typedef unsigned u32x4 __attribute__((ext_vector_type(4)));
constexpr int BM = 256, BK = 64, HALF = 128, HTB = HALF * BK * 2  , STAGE_BYTES = 8 * HTB, NXCD = 8, WGM = 4;

__host__ __device__ __forceinline__ int lds_byte(int r, int c) { const int st = (r >> 4) * 2 + (c >> 5), rr = r & 15, cc = c & 31, ob = rr * 64 + cc * 2; return st * 1024 + (ob ^ (((ob >> 9) & 1) << 5)); }
__host__ __device__ __forceinline__ void stage_rc(int b, int& R, int& C) { const int st = b / 1024, sb = b % 1024, swz = sb ^ (((sb >> 9) & 1) << 5); R = (st >> 1) * 16 + swz / 64; C = (st & 1) * 32 + (swz % 64) / 2; }
__host__ __device__ __forceinline__ int perm32(int rho) { const int n = rho >> 4, i = rho & 15; return 8 * (i >> 2) + 4 * n + (i & 3); }

struct Unit { int pm, pn; };
struct Gemm { const bf16_t* A; const bf16_t* Bt; int M, N, K; };

struct StaticOrder {
    int nM, nN, nwg, G, c, rep = 1;
    __host__ __device__ void init(int M, int N, int G_, int c_) { nM = M / BM; nN = N / BM; nwg = nM * nN; G = G_; c = c_; }
    __host__ __device__ bool next(int i, Unit& u) const {
        long L = (long)i * G + c; if (L >= (long)nwg * rep) return false;
        if (L >= nwg) L -= nwg;
        int wgid = (int)L; { const int q = nwg / NXCD, r = nwg % NXCD, xcd = wgid % NXCD, off = wgid / NXCD; wgid = (xcd < r ? xcd * (q + 1) : r * (q + 1) + (xcd - r) * q) + off; }
        const int nig = WGM * nN, gid = wgid / nig, fm = gid * WGM, gsz = (nM - fm) < WGM ? (nM - fm) : WGM;
        u.pm = fm + ((wgid % nig) % gsz); u.pn = (wgid % nig) / gsz; return true;
    }
    __device__ __forceinline__ void a_ready(const Unit&) const {}
    __device__ __forceinline__ void done(const Unit&) const {}
};

typedef float f32x2 __attribute__((ext_vector_type(2)));
typedef __bf16 bf16x2c __attribute__((ext_vector_type(2)));
__device__ __forceinline__ unsigned cvt_pk_bf16(float lo, float hi) { const f32x2 v = {lo, hi}; const bf16x2c b = __builtin_convertvector(v, bf16x2c); return __builtin_bit_cast(unsigned, b); }
template <class Epi, class Sched, bool ALIGN_EPI = false, bool SP2 = false>
__device__ __forceinline__ void gemm_phase(PG8_LAS unsigned char* lds, const Gemm g, const Sched& S, const Epi& E) {
    const int tid = threadIdx.x, wid = __builtin_amdgcn_readfirstlane(tid >> 6), lane = tid & 63, wr = wid >> 2, wc = wid & 3, fr = lane & 15, fq = lane >> 4;
    const int K = g.K, nt = K / BK;
    unsigned voffA[2], voffB[2];
#pragma unroll
    for (int i = 0; i < 2; ++i) { int R, C; stage_rc(tid * 16 + i * 8192, R, C); const int Rb = Epi::PERM ? ((R & ~31) + perm32(R & 31)) : R;
        voffA[i] = (unsigned)(R * K + C) * 2u; voffB[i] = (unsigned)(Rb * K + C) * 2u; }
    const size_t kstep = (size_t)(BK * 2);
    const size_t hstep = (size_t)HALF * K * 2;
    const size_t tstep = 2 * hstep;
    const unsigned ldsw = (unsigned)wid * 1024u;
    const int aoff = lds_byte(wr * 64 + fr, fq * 8), boff = lds_byte(wc * 32 + fr, fq * 8);
#define PG8_SA(b, h) (((b) * 2 + (h)) * HTB)
#define PG8_SB(b, h) ((4 + (b) * 2 + (h)) * HTB)
#define PG8_STAGE(bufoff, gbase, voff) do { _Pragma("unroll") for (int _i = 0; _i < 2; ++_i) \
        __builtin_amdgcn_global_load_lds((const unsigned*)((const char*)(gbase) + (voff)[_i]), (PG8_LAS unsigned*)(lds + (bufoff) + ldsw + _i * 8192), 16, 0, 0); } while (0)
#define PG8_LDA(dst, b, h) do { _Pragma("unroll") for (int m = 0; m < 4; ++m) _Pragma("unroll") for (int k = 0; k < 2; ++k) dst[m][k] = *(const PG8_LAS bf16x8*)(lds + PG8_SA(b, h) + aoff + m * 2048 + k * 1024); } while (0)
#define PG8_LDB(dst, b, h) do { _Pragma("unroll") for (int n = 0; n < 2; ++n) _Pragma("unroll") for (int k = 0; k < 2; ++k) dst[n][k] = *(const PG8_LAS bf16x8*)(lds + PG8_SB(b, h) + boff + n * 2048 + k * 1024); } while (0)
#define PG8_MMA(ai, bj, At, Bt) do { __builtin_amdgcn_s_setprio(1); _Pragma("unroll") for (int m = 0; m < 4; ++m) _Pragma("unroll") for (int n = 0; n < 2; ++n) _Pragma("unroll") for (int k = 0; k < 2; ++k) \
        acc[ai][bj][m][n] = __builtin_amdgcn_mfma_f32_16x16x32_bf16(Bt[n][k], At[m][k], acc[ai][bj][m][n], 0, 0, 0); __builtin_amdgcn_s_setprio(0); } while (0)
#define PG8_WAIT_V(n) asm volatile("s_waitcnt vmcnt(" #n ")" ::: "memory")
#define PG8_WAIT_L(n) asm volatile("s_waitcnt lgkmcnt(" #n ")" ::: "memory")
#define PG8_BAR __builtin_amdgcn_s_barrier()
#define PG8_SCHED __builtin_amdgcn_sched_barrier(0)
    Unit cur, nxt; int ui = 0;
    if (!S.next(0, cur)) return;
    f32x4 acc[2][2][4][2];
#pragma unroll
    for (int a = 0; a < 2; ++a)
#pragma unroll
        for (int b = 0; b < 2; ++b)
#pragma unroll
            for (int m = 0; m < 4; ++m)
#pragma unroll
                for (int n = 0; n < 2; ++n) acc[a][b][m][n] = (f32x4){0.f, 0.f, 0.f, 0.f};
    bf16x8 At[4][2], B0[2][2], B1[2][2];
    const char* cA = (const char*)g.A + (size_t)cur.pm * tstep; const char* cB = (const char*)g.Bt + (size_t)cur.pn * tstep;
    S.a_ready(cur);
    if constexpr (SP2) {
        PG8_STAGE(PG8_SB(0, 0), cB, voffB); PG8_STAGE(PG8_SB(0, 1), cB + hstep, voffB); PG8_STAGE(PG8_SA(0, 0), cA, voffA); PG8_STAGE(PG8_SA(0, 1), cA + hstep, voffA);
        if (wr == 1) PG8_BAR;
        PG8_WAIT_V(2); PG8_BAR;
        PG8_STAGE(PG8_SB(1, 0), cB + kstep, voffB); PG8_STAGE(PG8_SA(1, 0), cA + kstep, voffA); PG8_STAGE(PG8_SB(1, 1), cB + hstep + kstep, voffB);
        PG8_WAIT_V(6); PG8_BAR;
    } else {
        PG8_STAGE(PG8_SB(0, 0), cB, voffB); PG8_STAGE(PG8_SA(0, 0), cA, voffA); PG8_STAGE(PG8_SB(0, 1), cB + hstep, voffB); PG8_STAGE(PG8_SA(0, 1), cA + hstep, voffA);
        if (wr == 1) PG8_BAR;
        PG8_WAIT_V(4); PG8_BAR;
        PG8_STAGE(PG8_SB(1, 0), cB + kstep, voffB); PG8_STAGE(PG8_SA(1, 0), cA + kstep, voffA); PG8_STAGE(PG8_SB(1, 1), cB + hstep + kstep, voffB);
        PG8_WAIT_V(6); PG8_BAR;
    }
    for (;;) {
        const bool has_next = S.next(ui + 1, nxt);
        const char* nA = has_next ? (const char*)g.A + (size_t)nxt.pm * tstep : cA; const char* nB = has_next ? (const char*)g.Bt + (size_t)nxt.pn * tstep : cB;
        for (int t = 0; t < nt; t += 2) {
            const bool last = (t == nt - 2);
            const char* a1 = cA + (size_t)(t + 1) * kstep;
            const char* a2 = last ? nA : cA + (size_t)(t + 2) * kstep; const char* b2 = last ? nB : cB + (size_t)(t + 2) * kstep;
            const char* a3 = a2 + kstep; const char* b3 = b2 + kstep;
            if (last && has_next) S.a_ready(nxt);
            if constexpr (SP2) {
            PG8_LDB(B0, 0, 0); PG8_LDB(B1, 0, 1); PG8_SCHED; PG8_LDA(At, 0, 0); PG8_STAGE(PG8_SA(1, 1), a1 + hstep, voffA);
            PG8_WAIT_V(8); PG8_WAIT_L(0); PG8_BAR; PG8_MMA(0, 0, At, B0); PG8_MMA(0, 1, At, B1); PG8_BAR; PG8_SCHED;
            PG8_LDA(At, 0, 1); PG8_STAGE(PG8_SB(0, 0), b2, voffB); PG8_STAGE(PG8_SB(0, 1), b2 + hstep, voffB); PG8_STAGE(PG8_SA(0, 0), a2, voffA);
            PG8_WAIT_V(8); PG8_WAIT_L(0); PG8_BAR; PG8_MMA(1, 0, At, B0); PG8_MMA(1, 1, At, B1); PG8_BAR; PG8_SCHED;
            PG8_LDB(B0, 1, 0); PG8_LDB(B1, 1, 1); PG8_SCHED; PG8_LDA(At, 1, 0); PG8_STAGE(PG8_SA(0, 1), a2 + hstep, voffA);
            PG8_WAIT_V(8); PG8_WAIT_L(0); PG8_BAR; PG8_MMA(0, 0, At, B0); PG8_MMA(0, 1, At, B1); PG8_BAR; PG8_SCHED;
            PG8_LDA(At, 1, 1); PG8_STAGE(PG8_SB(1, 0), b3, voffB); PG8_STAGE(PG8_SB(1, 1), b3 + hstep, voffB); PG8_STAGE(PG8_SA(1, 0), a3, voffA);
            PG8_WAIT_V(8); PG8_WAIT_L(0); PG8_BAR; PG8_MMA(1, 0, At, B0); PG8_MMA(1, 1, At, B1); PG8_BAR; PG8_SCHED;
            } else {
            PG8_LDB(B0, 0, 0); PG8_SCHED; PG8_LDA(At, 0, 0); PG8_STAGE(PG8_SA(1, 1), a1 + hstep, voffA);
            PG8_WAIT_L(8); PG8_BAR; PG8_WAIT_L(0); PG8_MMA(0, 0, At, B0); PG8_BAR; PG8_SCHED;
            PG8_LDB(B1, 0, 1); PG8_STAGE(PG8_SB(0, 0), b2, voffB);
            PG8_BAR; PG8_WAIT_L(0); PG8_MMA(0, 1, At, B1); PG8_BAR;
            PG8_LDA(At, 0, 1); PG8_STAGE(PG8_SA(0, 0), a2, voffA);
            PG8_BAR; PG8_WAIT_L(0); PG8_MMA(1, 0, At, B0); PG8_BAR; PG8_SCHED;
            PG8_STAGE(PG8_SB(0, 1), b2 + hstep, voffB);
            PG8_WAIT_V(6); PG8_BAR; PG8_MMA(1, 1, At, B1); PG8_BAR;
            PG8_LDB(B0, 1, 0); PG8_SCHED; PG8_LDA(At, 1, 0); PG8_STAGE(PG8_SA(0, 1), a2 + hstep, voffA);
            PG8_WAIT_L(8); PG8_BAR; PG8_WAIT_L(0); PG8_MMA(0, 0, At, B0); PG8_BAR; PG8_SCHED;
            PG8_LDB(B1, 1, 1); PG8_STAGE(PG8_SB(1, 0), b3, voffB);
            PG8_BAR; PG8_WAIT_L(0); PG8_MMA(0, 1, At, B1); PG8_BAR;
            PG8_LDA(At, 1, 1); PG8_STAGE(PG8_SA(1, 0), a3, voffA);
            PG8_BAR; PG8_WAIT_L(0); PG8_MMA(1, 0, At, B0); PG8_BAR; PG8_SCHED;
            PG8_STAGE(PG8_SB(1, 1), b3 + hstep, voffB);
            PG8_WAIT_V(6); PG8_BAR; PG8_MMA(1, 1, At, B1); PG8_BAR;
            }
        }
        if constexpr (ALIGN_EPI) { if (wr == 0) PG8_BAR; }
        if constexpr (!Epi::AFTER_DRAIN) { E(acc, cur, wr, wc, fr, fq); S.done(cur); }
        if (!has_next) break;
#pragma unroll
        for (int a = 0; a < 2; ++a)
#pragma unroll
            for (int b = 0; b < 2; ++b)
#pragma unroll
                for (int m = 0; m < 4; ++m)
#pragma unroll
                    for (int n = 0; n < 2; ++n) acc[a][b][m][n] = (f32x4){0.f, 0.f, 0.f, 0.f};
        cur = nxt; cA = nA; cB = nB; ++ui;
        if constexpr (ALIGN_EPI) { if (wr == 1) PG8_BAR; }
    }
    PG8_WAIT_V(0);
    if constexpr (!ALIGN_EPI) { if (wr == 0) PG8_BAR; }
    PG8_BAR;
    if constexpr (Epi::AFTER_DRAIN) { E.fused(acc, cur, wr, wc, fr, fq, lds, wid, lane); S.done(cur); }
#undef PG8_SA
#undef PG8_SB
#undef PG8_STAGE
#undef PG8_LDA
#undef PG8_LDB
#undef PG8_MMA
#undef PG8_WAIT_V
#undef PG8_WAIT_L
#undef PG8_BAR
#undef PG8_SCHED
}
}

namespace pg8 {
__device__ __forceinline__ float sigm(float v) { return __builtin_amdgcn_rcpf(1.f + __builtin_amdgcn_exp2f(-1.4426950408889634f * v)); }
struct EpiPlain {
    static constexpr bool PERM = true, AFTER_DRAIN = false;
    bf16_t* O; int ldc; float scale;
    __device__ __forceinline__ void operator()(const f32x4 (&acc)[2][2][4][2], const Unit& u, int wr, int wc, int fr, int fq) const {
        const int row0 = u.pm * BM + wr * 64 + fr, col0 = u.pn * BM + wc * 32 + 8 * fq;
#pragma unroll
        for (int ai = 0; ai < 2; ++ai)
#pragma unroll
            for (int m = 0; m < 4; ++m) { bf16_t* rowp = O + (size_t)(row0 + ai * HALF + m * 16) * ldc + col0;
#pragma unroll
                for (int bj = 0; bj < 2; ++bj) { const f32x4 v0 = acc[ai][bj][m][0] * scale, v1 = acc[ai][bj][m][1] * scale;
                    u32x4 w; w.x = cvt_pk_bf16(v0[0], v0[1]); w.y = cvt_pk_bf16(v0[2], v0[3]); w.z = cvt_pk_bf16(v1[0], v1[1]); w.w = cvt_pk_bf16(v1[2], v1[3]);
                    *(u32x4*)(rowp + bj * HALF) = w; } }
    }
};
struct EpiGlu {
    static constexpr bool PERM = true, AFTER_DRAIN = false;
    bf16_t* G; bf16_t* SZ;
    __device__ __forceinline__ void operator()(const f32x4 (&acc)[2][2][4][2], const Unit& u, int wr, int wc, int fr, int fq) const {
        const int row0 = u.pm * BM + wr * 64 + fr;
        if (u.pn < 8) {
            const int col0 = u.pn * HALF + wc * 32 + 8 * fq;
#pragma unroll
            for (int ai = 0; ai < 2; ++ai)
#pragma unroll
                for (int m = 0; m < 4; ++m) { bf16_t* rowp = G + (size_t)(row0 + ai * HALF + m * 16) * 1024 + col0;
                    f32x4 v0, v1;
#pragma unroll
                    for (int j = 0; j < 4; ++j) { v0[j] = acc[ai][0][m][0][j] * sigm(acc[ai][1][m][0][j]); v1[j] = acc[ai][0][m][1][j] * sigm(acc[ai][1][m][1][j]); }
                    u32x4 w; w.x = cvt_pk_bf16(v0[0], v0[1]); w.y = cvt_pk_bf16(v0[2], v0[3]); w.z = cvt_pk_bf16(v1[0], v1[1]); w.w = cvt_pk_bf16(v1[2], v1[3]);
                    *(u32x4*)rowp = w; }
        } else {
            const int col0 = (u.pn - 8) * BM + wc * 32 + 8 * fq;
#pragma unroll
            for (int ai = 0; ai < 2; ++ai)
#pragma unroll
                for (int m = 0; m < 4; ++m) { bf16_t* rowp = SZ + (size_t)(row0 + ai * HALF + m * 16) * 1024 + col0;
#pragma unroll
                    for (int bj = 0; bj < 2; ++bj) { f32x4 v0 = acc[ai][bj][m][0], v1 = acc[ai][bj][m][1];
#pragma unroll
                        for (int j = 0; j < 4; ++j) { v0[j] = v0[j] * sigm(v0[j]); v1[j] = v1[j] * sigm(v1[j]); }
                        u32x4 w; w.x = cvt_pk_bf16(v0[0], v0[1]); w.y = cvt_pk_bf16(v0[2], v0[3]); w.z = cvt_pk_bf16(v1[0], v1[1]); w.w = cvt_pk_bf16(v1[2], v1[3]);
                        *(u32x4*)(rowp + bj * HALF) = w; } }
        }
    }
};
struct EpiKQZ {
    static constexpr bool PERM = true, AFTER_DRAIN = false;
    bf16_t* Kb; size_t seg_stride; float qscale;
    __device__ __forceinline__ void operator()(const f32x4 (&acc)[2][2][4][2], const Unit& u, int wr, int wc, int fr, int fq) const {
        const int row0 = u.pm * BM + wr * 64 + fr; const int seg = u.pn >> 2;
        bf16_t* base = Kb + (size_t)seg * seg_stride;
        const float sc = seg == 1 ? qscale : 1.f;
        const int col0 = (u.pn & 3) * BM + wc * 32 + 8 * fq;
#pragma unroll
        for (int ai = 0; ai < 2; ++ai)
#pragma unroll
            for (int m = 0; m < 4; ++m) { bf16_t* rowp = base + (size_t)(row0 + ai * HALF + m * 16) * 1024 + col0;
#pragma unroll
                for (int bj = 0; bj < 2; ++bj) { f32x4 v0 = acc[ai][bj][m][0] * sc, v1 = acc[ai][bj][m][1] * sc;
                    if (seg == 2) {
#pragma unroll
                        for (int j = 0; j < 4; ++j) { v0[j] = v0[j] * sigm(v0[j]); v1[j] = v1[j] * sigm(v1[j]); } }
                    u32x4 w; w.x = cvt_pk_bf16(v0[0], v0[1]); w.y = cvt_pk_bf16(v0[2], v0[3]); w.z = cvt_pk_bf16(v1[0], v1[1]); w.w = cvt_pk_bf16(v1[2], v1[3]);
                    *(u32x4*)(rowp + bj * HALF) = w; } }
    }
};
}

#define LAS __attribute__((address_space(3)))
typedef pg8::bf16_t bf16_t;
typedef pg8::bf16x8 bf16x8;
typedef pg8::f32x4 f32x4;
typedef pg8::u32x4 u32x4;
typedef float f32x16 __attribute__((ext_vector_type(16)));
typedef float f32x2v __attribute__((ext_vector_type(2)));
typedef unsigned u32x2 __attribute__((ext_vector_type(2)));

constexpr int BATCH = 16, SEQ = 2048, DM = 1024, MTOK = BATCH * SEQ;
constexpr int NH = 8, CK = 31;
constexpr float EPS = 1e-6f;
constexpr float LOG2E = 1.4426950408889634f;
constexpr float LAM_INIT = 0.4707130183435842f;
constexpr int NTHREADS = 512, NWAVES = 8;
constexpr int NRF0 = 8;
constexpr int NRF = 4;
constexpr int LDS_BYTES = 163840;
constexpr size_t MiB = 1u << 20;
constexpr size_t WS_WT1 = 0, WS_WT2 = 6 * MiB, WS_WT3 = 8 * MiB, WS_WT3V = 14 * MiB, WS_WT4 = 16 * MiB;
constexpr size_t WS_RS0 = 22 * MiB;
constexpr size_t WS_RS = 21 * MiB;
constexpr size_t WS_CTL = 20 * MiB, CTL_BYTES = 16384;
constexpr size_t WS_A = 32 * MiB, WS_B = 96 * MiB, WS_C = 160 * MiB, WS_F = 224 * MiB, WS_G = 288 * MiB, WS_H = 352 * MiB, WS_END = 416 * MiB;

struct Args { const float* in[17]; float* out; unsigned char* ws; int ph_lo, ph_hi; };

__device__ __forceinline__ float wave_sum(float v) {
#pragma unroll
    for (int o = 1; o < 64; o <<= 1) v += __shfl_xor(v, o);
    return v;
}
typedef __bf16 bf16x2_t __attribute__((ext_vector_type(2)));
__device__ __forceinline__ unsigned pk2(float lo, float hi) { const f32x2v v = {lo, hi}; const bf16x2_t b = __builtin_convertvector(v, bf16x2_t); return __builtin_bit_cast(unsigned, b); }
__device__ __forceinline__ float bflo(unsigned u) { return __builtin_bit_cast(float, u << 16); }
__device__ __forceinline__ float bfhi(unsigned u) { return __builtin_bit_cast(float, u & 0xffff0000u); }
#define LDS_WAIT() asm volatile("s_waitcnt lgkmcnt(0)" ::: "memory")

__device__ __forceinline__ void transpose_item(const float* W, int ldw, int col0, const float* gain, bf16_t* WT, int dst_row0, LAS float* scr, int kb, int lane) {
    const int k0 = 64 * kb;
    float wv[32];
#pragma unroll
    for (int i = 0; i < 32; ++i) { const int kk = 2 * i + (lane >> 5); wv[i] = W[(size_t)(k0 + kk) * ldw + col0 + (lane & 31)]; }
#pragma unroll
    for (int i = 0; i < 32; ++i) { const int kk = 2 * i + (lane >> 5); const float gg = gain ? gain[k0 + kk] : 1.f; scr[kk * 33 + (lane & 31)] = wv[i] * gg; }
    LDS_WAIT();
    const int c = lane & 7;
#pragma unroll
    for (int j = 0; j < 4; ++j) { const int n = (lane >> 3) + 8 * j; const LAS float* s = scr + (8 * c) * 33 + n;
        u32x4 o; o.x = pk2(s[0 * 33], s[1 * 33]); o.y = pk2(s[2 * 33], s[3 * 33]); o.z = pk2(s[4 * 33], s[5 * 33]); o.w = pk2(s[6 * 33], s[7 * 33]);
        *(u32x4*)(WT + (size_t)(dst_row0 + n) * 1024 + k0 + 8 * c) = o; }
    LDS_WAIT();
}

__device__ __forceinline__ void rms_row_to_bf16(const float* xrow, bf16_t* orow, int lane) {
    const f32x4* xr = (const f32x4*)xrow + lane;
    f32x4 v[4]; float s = 0.f;
#pragma unroll
    for (int j = 0; j < 4; ++j) { v[j] = xr[64 * j]; s += (v[j].x * v[j].x + v[j].y * v[j].y) + (v[j].z * v[j].z + v[j].w * v[j].w); }
    const float r = rsqrtf(wave_sum(s) * (1.f / DM) + EPS);
    u32x2* o8 = (u32x2*)orow + lane;
#pragma unroll
    for (int j = 0; j < 4; ++j) { u32x2 w; w.x = pk2(v[j].x * r, v[j].y * r); w.y = pk2(v[j].z * r, v[j].w * r); o8[64 * j] = w; }
}

__device__ __forceinline__ void p0_phase(const Args& a, LAS unsigned char* lds, int lane, int wave) {
    LAS float* scr = (LAS float*)(lds + wave * 16384);
    constexpr int NWT = 2, NWR = NWAVES - NWT;
    unsigned char* ws = a.ws;
    const bool is_tw = wave >= NWR;
    const int gw = is_tw ? blockIdx.x * NWT + (wave - NWR) : blockIdx.x * NWR + wave, NGW = is_tw ? gridDim.x * NWT : gridDim.x * NWR;
    if (is_tw)
    for (int it = gw; it < 9 * 512; it += NGW) {
        const int piece = it >> 9, r = it & 511, kb = r >> 5, cb = (r & 31) * 32;
        switch (piece) {
        case 0: transpose_item(a.in[2], 3072, cb, a.in[1], (bf16_t*)(ws + WS_WT1), (cb >> 7) * 256 + (cb & 127), scr, kb, lane); break;
        case 1: transpose_item(a.in[2], 3072, 1024 + cb, a.in[1], (bf16_t*)(ws + WS_WT1), (cb >> 7) * 256 + 128 + (cb & 127), scr, kb, lane); break;
        case 2: transpose_item(a.in[2], 3072, 2048 + cb, a.in[1], (bf16_t*)(ws + WS_WT1), 2048 + cb, scr, kb, lane); break;
        case 3: transpose_item(a.in[7], 1024, cb, nullptr, (bf16_t*)(ws + WS_WT2), cb, scr, kb, lane); break;
        case 4: transpose_item(a.in[10], 2048, cb, a.in[9], (bf16_t*)(ws + WS_WT3), cb, scr, kb, lane); break;
        case 5: transpose_item(a.in[10], 2048, 1024 + cb, a.in[9], (bf16_t*)(ws + WS_WT3V), cb, scr, kb, lane); break;
        case 6: transpose_item(a.in[12], 2048, cb, a.in[11], (bf16_t*)(ws + WS_WT3), 1024 + cb, scr, kb, lane); break;
        case 7: transpose_item(a.in[12], 2048, 1024 + cb, a.in[11], (bf16_t*)(ws + WS_WT3), 2048 + cb, scr, kb, lane); break;
        default: transpose_item(a.in[15], 1024, cb, nullptr, (bf16_t*)(ws + WS_WT4), cb, scr, kb, lane); break;
        }
    }
    bf16_t* xn0 = (bf16_t*)(ws + WS_A);
    if (!is_tw)
    for (int m0 = gw; m0 < MTOK; m0 += NRF0 * NGW) {
        f32x4 v[NRF0][4];
#pragma unroll
        for (int rr = 0; rr < NRF0; ++rr) { const int m = m0 + rr * NGW; if (m < MTOK) { const f32x4* xr = (const f32x4*)(a.in[0] + (size_t)m * DM) + lane;
#pragma unroll
            for (int j = 0; j < 4; ++j) v[rr][j] = __builtin_nontemporal_load(xr + 64 * j); } }
#pragma unroll
        for (int rr = 0; rr < NRF0; ++rr) { const int m = m0 + rr * NGW; if (m < MTOK) { float sq = 0.f;
#pragma unroll
            for (int j = 0; j < 4; ++j) sq += (v[rr][j].x * v[rr][j].x + v[rr][j].y * v[rr][j].y) + (v[rr][j].z * v[rr][j].z + v[rr][j].w * v[rr][j].w);
            const float r = rsqrtf(wave_sum(sq) * (1.f / DM) + EPS);
            if (lane == 0) ((float*)(ws + WS_RS0))[m] = 1.f / r;
            u32x2* o8 = (u32x2*)(xn0 + (size_t)m * DM) + lane;
#pragma unroll
            for (int j = 0; j < 4; ++j) { u32x2 w; w.x = pk2(v[rr][j].x * r, v[rr][j].y * r); w.y = pk2(v[rr][j].z * r, v[rr][j].w * r); o8[64 * j] = w; } } }
    }
}

#define RS_STEP(N, MASK) { const bool up_ = (lane & (MASK)) != 0; _Pragma("unroll") for (int i_ = 0; i_ < (N) / 2; ++i_) { \
        const float keep_ = up_ ? rv[i_ + (N) / 2] : rv[i_], send_ = up_ ? rv[i_] : rv[i_ + (N) / 2]; rv[i_] = keep_ + __shfl_xor(send_, (MASK)); } }
__device__ __forceinline__ void conv_phase(LAS unsigned char* lds, const bf16_t* g, const bf16_t* sz, bf16_t* cgo,
                                           const float* wdw, const float* bdw, const float* lng, const float* lnb) {
    const int tid = threadIdx.x, lane = tid & 63, wave = tid >> 6;
    LAS float* red = (LAS float*)(lds + 131072);
    LAS float* stat = red + 128;
    f32x2v w[CK];
#pragma unroll
    for (int k = 0; k < CK; ++k) w[k] = *(const f32x2v*)(wdw + k * 1024 + 2 * tid);
    const f32x2v bb = *(const f32x2v*)(bdw + 2 * tid), lg = *(const f32x2v*)(lng + 2 * tid), lb = *(const f32x2v*)(lnb + 2 * tid);
    for (int chunk = blockIdx.x; chunk < MTOK / 128; chunk += gridDim.x) {
        const int c0 = chunk * 128, s0 = c0 & (SEQ - 1);
        __syncthreads();
        for (int id = tid; id < 62 * 128; id += NTHREADS) { const int row = id >> 7, ch = id & 127;
            u32x4 v = {0u, 0u, 0u, 0u};
            if (s0 - 30 + row >= 0) v = *(const u32x4*)(g + (size_t)(c0 - 30 + row) * 1024 + ch * 8);
            *(LAS u32x4*)(lds + row * 2048 + ch * 16) = v; }
        __syncthreads();
#pragma unroll 1
        for (int tile = 0; tile < 4; ++tile) {
            u32x4 pf[8];
            if (tile < 3) {
#pragma unroll
                for (int i = 0; i < 8; ++i) { const int id = tid + NTHREADS * i; pf[i] = __builtin_nontemporal_load((const u32x4*)(g + (size_t)(c0 + 32 + 32 * tile + (id >> 7)) * 1024 + (id & 127) * 8)); } }
#pragma unroll 1
            for (int gq = 0; gq < 4; ++gq) {
                const int rbase = (32 * tile + 8 * gq) & 63;
                f32x2v v[38];
#pragma unroll
                for (int i = 0; i < 38; ++i) { const int slot = (rbase + i) & 63; const unsigned u = *(const LAS unsigned*)(lds + slot * 2048 + tid * 4); v[i] = (f32x2v){bflo(u), bfhi(u)}; }
                unsigned zz[8];
#pragma unroll
                for (int tt = 0; tt < 8; ++tt) zz[tt] = *(const unsigned*)(sz + (size_t)(c0 + 32 * tile + gq * 8 + tt) * 1024 + 2 * tid);
                f32x2v cv[8];
#pragma unroll
                for (int tt = 0; tt < 8; ++tt) { f32x2v acc = bb;
#pragma unroll
                    for (int k = 0; k < CK; ++k) acc = __builtin_elementwise_fma(w[k], v[tt + k], acc);
                    cv[tt] = acc; }
                float rv[16];
#pragma unroll
                for (int tt = 0; tt < 8; ++tt) { rv[2 * tt] = cv[tt].x + cv[tt].y; rv[2 * tt + 1] = cv[tt].x * cv[tt].x + cv[tt].y * cv[tt].y; }
                RS_STEP(16, 32) RS_STEP(8, 16) RS_STEP(4, 8) RS_STEP(2, 4)
                rv[0] += __shfl_xor(rv[0], 2); rv[0] += __shfl_xor(rv[0], 1);
                if ((lane & 3) == 0) red[wave * 16 + (lane >> 2)] = rv[0];
                __syncthreads();
                if (tid < 8) { float s = 0.f, q = 0.f;
#pragma unroll
                    for (int ww = 0; ww < 8; ++ww) { s += red[ww * 16 + 2 * tid]; q += red[ww * 16 + 2 * tid + 1]; }
                    const float mu = s * (1.f / 1024.f), var = fmaxf(q * (1.f / 1024.f) - mu * mu, 0.f);
                    stat[2 * tid] = mu; stat[2 * tid + 1] = rsqrtf(var + EPS); }
                __syncthreads();
#pragma unroll
                for (int tt = 0; tt < 8; ++tt) { const float mu = stat[2 * tt], rs = stat[2 * tt + 1];
                    float n0 = (cv[tt].x - mu) * rs * lg.x + lb.x, n1 = (cv[tt].y - mu) * rs * lg.y + lb.y;
                    n0 = n0 * pg8::sigm(n0) * bflo(zz[tt]); n1 = n1 * pg8::sigm(n1) * bfhi(zz[tt]);
                    *(unsigned*)(cgo + (size_t)(c0 + 32 * tile + gq * 8 + tt) * 1024 + 2 * tid) = pk2(n0, n1); }
            }
            if (tile < 3) {
#pragma unroll
                for (int i = 0; i < 8; ++i) { const int id = tid + NTHREADS * i; const int slot = (62 + 32 * tile + (id >> 7)) & 63;
                    *(LAS u32x4*)(lds + slot * 2048 + (id & 127) * 16) = pf[i]; }
                __syncthreads();
            }
        }
    }
}

template <bool FIRST>
__device__ __forceinline__ void resid_phase(const bf16_t* xinb, const float* rs_in, const bf16_t* y, const float* gpost, float* xout, float* rs_out, bf16_t* xn, int lane, int wave) {
    const int gw = blockIdx.x * NWAVES + wave, NGW = gridDim.x * NWAVES;
    f32x4 gp[4];
#pragma unroll
    for (int j = 0; j < 4; ++j) gp[j] = ((const f32x4*)gpost)[lane + 64 * j];
    for (int m0 = gw; m0 < MTOK; m0 += NRF * NGW) {
        f32x4 xv[NRF][4], yv[NRF][4]; float s[NRF];
#pragma unroll
        for (int rr = 0; rr < NRF; ++rr) s[rr] = 0.f;
#pragma unroll
        for (int rr = 0; rr < NRF; ++rr) { const int m = m0 + rr * NGW; if (m < MTOK) {
            const u32x2* yr = (const u32x2*)(y + (size_t)m * DM) + lane;
            { const u32x2* xr = (const u32x2*)(xinb + (size_t)m * DM) + lane; const float rsc = rs_in[m];
#pragma unroll
                for (int j = 0; j < 4; ++j) { const u32x2 u = __builtin_nontemporal_load(xr + 64 * j); xv[rr][j] = (f32x4){bflo(u.x), bfhi(u.x), bflo(u.y), bfhi(u.y)} * rsc; } }
#pragma unroll
            for (int j = 0; j < 4; ++j) { const u32x2 u = __builtin_nontemporal_load(yr + 64 * j); yv[rr][j] = (f32x4){bflo(u.x), bfhi(u.x), bflo(u.y), bfhi(u.y)}; } } }
#pragma unroll
        for (int rr = 0; rr < NRF; ++rr) { const int m = m0 + rr * NGW; if (m < MTOK) {
#pragma unroll
            for (int j = 0; j < 4; ++j) s[rr] += (yv[rr][j].x * yv[rr][j].x + yv[rr][j].y * yv[rr][j].y) + (yv[rr][j].z * yv[rr][j].z + yv[rr][j].w * yv[rr][j].w);
            const float r = rsqrtf(wave_sum(s[rr]) * (1.f / DM) + EPS);
            float s1 = 0.f;
#pragma unroll
            for (int j = 0; j < 4; ++j) { xv[rr][j] = xv[rr][j] + yv[rr][j] * r * gp[j];
                s1 += (xv[rr][j].x * xv[rr][j].x + xv[rr][j].y * xv[rr][j].y) + (xv[rr][j].z * xv[rr][j].z + xv[rr][j].w * xv[rr][j].w); }
            if (FIRST) {
                const float r1 = rsqrtf(wave_sum(s1) * (1.f / DM) + EPS);
                u32x2* o8 = (u32x2*)(xn + (size_t)m * DM) + lane;
                if (lane == 0) rs_out[m] = 1.f / r1;
#pragma unroll
                for (int j = 0; j < 4; ++j) { u32x2 w; w.x = pk2(xv[rr][j].x * r1, xv[rr][j].y * r1); w.y = pk2(xv[rr][j].z * r1, xv[rr][j].w * r1); o8[64 * j] = w; }
            } else {
                f32x4* xo = (f32x4*)(xout + (size_t)m * DM) + lane;
#pragma unroll
                for (int j = 0; j < 4; ++j) __builtin_nontemporal_store(xv[rr][j], xo + 64 * j);
            } } }
    }
}
#define XB_TMO      128
#define XB_XCNT(j)  (256  + 64 * (j))
#define XB_XSUB(j)  (1280 + 64 * (j))
#define XB_XGEN(j)  (2304 + 64 * (j))
#define XB_TOP      3328
#define XB_TOPGEN   3392
#define XCD_BAR_WORDS 3456
#define XB_SPIN_CAP (1u << 18)

__device__ __forceinline__ unsigned xb_ld(unsigned* p)              { return __hip_atomic_load(p, __ATOMIC_RELAXED, __HIP_MEMORY_SCOPE_AGENT); }
__device__ __forceinline__ unsigned xb_add(unsigned* p, unsigned v) { return __hip_atomic_fetch_add(p, v, __ATOMIC_RELAXED, __HIP_MEMORY_SCOPE_AGENT); }
__device__ __forceinline__ unsigned xb_xcc_id() { return (unsigned)__builtin_amdgcn_s_getreg((3 << 11) | 20) & 0xFu; }
#define XB_SPIN(cond, bar) do { unsigned _sp = 0; while (cond) { __builtin_amdgcn_s_sleep(1); \
    if ((++_sp & 255u) == 0u) { if (xb_ld(&(bar)[XB_TMO])) break; if (_sp > XB_SPIN_CAP) { atomicAdd(&(bar)[XB_TMO], 1u); break; } } } } while (0)

struct XcdBarrier {
    unsigned* bar; unsigned x, nloc, nx;
};

__device__ __forceinline__ void xcd_barrier_complete(unsigned* bar, unsigned x, unsigned& nloc, unsigned& nx) {
    const unsigned G = gridDim.x * gridDim.y * gridDim.z;
    unsigned sum, cnt, mine, sp = 0u;
    for (;;) {
        sum = 0u; cnt = 0u; mine = 0u;
#pragma unroll
        for (unsigned j = 0; j < 16; ++j) { const unsigned c = xb_ld(&bar[XB_XCNT(j)]); sum += c; cnt += (c > 0u) ? 1u : 0u; mine = (j == x) ? c : mine; }
        if (sum == G) break;
        __builtin_amdgcn_s_sleep(1);
        if ((++sp & 255u) == 0u) { if (xb_ld(&bar[XB_TMO])) break; if (sp > XB_SPIN_CAP) { atomicAdd(&bar[XB_TMO], 1u); break; } }
    }
    nloc = mine > 0u ? mine : 1u; nx = cnt > 0u ? cnt : 1u;
}

__device__ __forceinline__ void xcd_barrier(const XcdBarrier& b) {
    asm volatile("s_waitcnt vmcnt(0)" ::: "memory");
    __syncthreads();
    if (threadIdx.x == 0) {
        unsigned* bar = b.bar;
        __builtin_amdgcn_s_waitcnt(0);
        const unsigned nloc = b.nloc, nx = b.nx;
        const unsigned old = xb_add(&bar[XB_XSUB(b.x)], 1u);
        const unsigned gen = old / nloc;
        if (old + 1u == (gen + 1u) * nloc) {
            __builtin_amdgcn_fence(__ATOMIC_RELEASE, "agent");
            asm volatile("s_waitcnt vmcnt(0)" ::: "memory");
            const unsigned og = xb_add(&bar[XB_TOP], 1u);
            const unsigned tg = og / nx;
            if (og + 1u == (tg + 1u) * nx) xb_add(&bar[XB_TOPGEN], 1u);
            else XB_SPIN(xb_ld(&bar[XB_TOPGEN]) == tg, bar);
            __builtin_amdgcn_fence(__ATOMIC_ACQUIRE, "agent");
            xb_add(&bar[XB_XGEN(b.x)], 1u);
            asm volatile("s_waitcnt vmcnt(0)" ::: "memory");
        } else {
            XB_SPIN(xb_ld(&bar[XB_XGEN(b.x)]) == gen, bar);
            __builtin_amdgcn_fence(__ATOMIC_ACQUIRE, "agent");
            asm volatile("s_waitcnt vmcnt(0)" ::: "memory");
        }
    }
    __syncthreads();
}
__device__ __forceinline__ XcdBarrier xcd_barrier_init(unsigned* bar, volatile LAS unsigned* tmp) {
    XcdBarrier b; b.bar = bar; b.x = xb_xcc_id();
    if (threadIdx.x == 0) { (void)xb_add(&bar[XB_XCNT(b.x)], 1u); unsigned nloc, nx; xcd_barrier_complete(bar, b.x, nloc, nx); tmp[0] = nloc; tmp[1] = nx; }
    __syncthreads();
    b.nloc = (unsigned)__builtin_amdgcn_readfirstlane((int)tmp[0]); b.nx = (unsigned)__builtin_amdgcn_readfirstlane((int)tmp[1]);
    __syncthreads();
    return b;
}


constexpr int KT_BYTES = 64 * 256, VT_BYTES = 128 * 128, NBUF = 3, LDS_VOFF = NBUF * KT_BYTES, LDS_QOFF = NBUF * (KT_BYTES + VT_BYTES);
typedef short v4i16_t __attribute__((ext_vector_type(4)));
__device__ __forceinline__ v4i16_t vtr16(const LAS unsigned char* p) { return __builtin_amdgcn_ds_read_tr16_b64_v4i16((LAS v4i16_t*)p); }
__device__ __forceinline__ int pi32(int i) { return (i & ~12) | ((i & 4) << 1) | ((i & 8) >> 1); }
__device__ __forceinline__ float hmax32(float v) { auto rr = __builtin_amdgcn_permlane32_swap(__float_as_uint(v), __float_as_uint(v), false, false); return fmaxf(__uint_as_float(rr[0]), __uint_as_float(rr[1])); }
__device__ __forceinline__ float hsum32(float v) { auto rr = __builtin_amdgcn_permlane32_swap(__float_as_uint(v), __float_as_uint(v), false, false); return __uint_as_float(rr[0]) + __uint_as_float(rr[1]); }

template <bool DIAG>
__device__ __forceinline__ void attn_sub(f32x16 (&O)[2][4], const LAS unsigned char* qlds, float (&mrun)[2], float (&lrun)[2],
                                         const LAS unsigned char* const (&kptr)[2][4], const LAS unsigned char* const (&vptr)[4][2], int koff, int voff, const f32x16& cinit, float cb, int j32, int hi, bool isdiag) {
    f32x16 x0, x1;
#pragma unroll
    for (int sh = 0; sh < 2; ++sh) {
        bf16x8 kf[2][2], qv[2][2];
#pragma unroll
        for (int c = 0; c < 2; ++c)
#pragma unroll
            for (int s2 = 0; s2 < 2; ++s2) { kf[c][s2] = *(const LAS bf16x8*)(kptr[c][sh * 2 + s2] + koff); qv[c][s2] = *(const LAS bf16x8*)(qlds + (c * 4 + sh * 2 + s2) * 1024); }
        if (sh == 0) {
            x0 = __builtin_amdgcn_mfma_f32_32x32x16_bf16(kf[0][0], qv[0][0], cinit, 0, 0, 0); x1 = __builtin_amdgcn_mfma_f32_32x32x16_bf16(kf[1][0], qv[1][0], cinit, 0, 0, 0);
            x0 = __builtin_amdgcn_mfma_f32_32x32x16_bf16(kf[0][1], qv[0][1], x0, 0, 0, 0); x1 = __builtin_amdgcn_mfma_f32_32x32x16_bf16(kf[1][1], qv[1][1], x1, 0, 0, 0);
        } else {
#pragma unroll
            for (int s2 = 0; s2 < 2; ++s2) { x0 = __builtin_amdgcn_mfma_f32_32x32x16_bf16(kf[0][s2], qv[0][s2], x0, 0, 0, 0); x1 = __builtin_amdgcn_mfma_f32_32x32x16_bf16(kf[1][s2], qv[1][s2], x1, 0, 0, 0); }
        }
        __builtin_amdgcn_sched_barrier(0);
    }
    if (isdiag) {
#pragma unroll
        for (int r = 0; r < 16; ++r) { const int kk = 16 * (r >> 3) + 8 * hi + (r & 7); if (kk > j32) { x0[r] = -INFINITY; x1[r] = -INFINITY; } } }
    float mx0 = fmaxf(x0[0], x0[1]), mx1 = fmaxf(x1[0], x1[1]);
#pragma unroll
    for (int r = 2; r < 16; r += 2) { mx0 = fmaxf(fmaxf(mx0, x0[r]), x0[r + 1]); mx1 = fmaxf(fmaxf(mx1, x1[r]), x1[r + 1]); }
    const float mc0 = hmax32(mx0) + cb, mc1 = hmax32(mx1) + cb;
    if (__any((mc0 > mrun[0] + 8.f) || (mc1 > mrun[1] + 8.f))) {
        const float mn0 = fmaxf(mrun[0], mc0), al0 = __builtin_amdgcn_exp2f(mrun[0] - mn0), mn1 = fmaxf(mrun[1], mc1), al1 = __builtin_amdgcn_exp2f(mrun[1] - mn1);
        lrun[0] *= al0; lrun[1] *= al1; mrun[0] = mn0; mrun[1] = mn1;
#pragma unroll
        for (int dt = 0; dt < 4; ++dt)
#pragma unroll
            for (int r = 0; r < 16; ++r) { O[0][dt][r] *= al0; O[1][dt][r] *= al1; }
    }
    const float off0 = cb - mrun[0], off1 = cb - mrun[1];
    float ls0 = 0.f, ls1 = 0.f;
#pragma unroll
    for (int r = 0; r < 16; ++r) { x0[r] = __builtin_amdgcn_exp2f(x0[r] + off0); ls0 += x0[r]; x1[r] = __builtin_amdgcn_exp2f(x1[r] + off1); ls1 += x1[r]; }
    lrun[0] += ls0; lrun[1] += ls1;
    bf16x8 p0[2], p1[2];
#pragma unroll
    for (int t = 0; t < 2; ++t) {
        p0[t] = __builtin_bit_cast(bf16x8, (u32x4){pk2(x0[8 * t], x0[8 * t + 1]), pk2(x0[8 * t + 2], x0[8 * t + 3]), pk2(x0[8 * t + 4], x0[8 * t + 5]), pk2(x0[8 * t + 6], x0[8 * t + 7])});
        p1[t] = __builtin_bit_cast(bf16x8, (u32x4){pk2(x1[8 * t], x1[8 * t + 1]), pk2(x1[8 * t + 2], x1[8 * t + 3]), pk2(x1[8 * t + 4], x1[8 * t + 5]), pk2(x1[8 * t + 6], x1[8 * t + 7])}); }
#pragma unroll
    for (int dt = 0; dt < 4; ++dt) {
        bf16x8 vf[2];
#pragma unroll
        for (int t = 0; t < 2; ++t) { const v4i16_t lo_ = vtr16(vptr[dt][0] + voff + t * 4096), hi_ = vtr16(vptr[dt][1] + voff + t * 4096);
            vf[t] = (bf16x8){lo_[0], lo_[1], lo_[2], lo_[3], hi_[0], hi_[1], hi_[2], hi_[3]}; }
#pragma unroll
        for (int t = 0; t < 2; ++t) {
            O[0][dt] = __builtin_amdgcn_mfma_f32_32x32x16_bf16(vf[t], p0[t], O[0][dt], 0, 0, 0);
            O[1][dt] = __builtin_amdgcn_mfma_f32_32x32x16_bf16(vf[t], p1[t], O[1][dt], 0, 0, 0); }
    }
}

__device__ __forceinline__ void attn_unit(LAS unsigned char* lds, int b, int h, int qb, const bf16_t* Qb, const bf16_t* Kb, const bf16_t* VT, const bf16_t* Zs, bf16_t* og,
                                          const float* gsub, float lam) {
    const int tid = threadIdx.x, lane = tid & 63, j32 = lane & 31, hi = lane >> 5; const int wid = __builtin_amdgcn_readfirstlane(tid >> 6);
    const float sl2 = exp2f(-(float)(h + 1)) * LOG2E;
    const size_t tokbase = (size_t)b * SEQ;
    const int q0w = qb * 256 + wid * 32, qpos = q0w + j32;
    LAS unsigned char* qlds = lds + LDS_QOFF + wid * 8192 + lane * 16;
    { const bf16_t* qp = Qb + (tokbase + qpos) * 1024 + h * 128 + hi * 8;
#pragma unroll
      for (int c = 0; c < 2; ++c)
#pragma unroll
          for (int s = 0; s < 4; ++s) *(LAS bf16x8*)(qlds + (c * 4 + s) * 1024) = *(const bf16x8*)(qp + c * 64 + s * 16); }
    f32x16 O[2][4];
#pragma unroll
    for (int c = 0; c < 2; ++c)
#pragma unroll
        for (int dt = 0; dt < 4; ++dt)
#pragma unroll
            for (int r = 0; r < 16; ++r) O[c][dt][r] = 0.f;
    float mrun[2] = {-1e30f, -1e30f}, lrun[2] = {0.f, 0.f};
    f32x16 cinit;
    { int hio = hi; asm volatile("" : "+v"(hio));
#pragma unroll
      for (int r = 0; r < 16; ++r) cinit[r] = sl2 * (float)(16 * (r >> 3) + 8 * hio + (r & 7)); }
    const int nsub_w = qb * 8 + wid + 1, NT = 4 * qb + 4;
    const bf16_t* Kbh = Kb + tokbase * 1024 + h * 128;
    const bf16_t* Vbh = VT + tokbase * 1024 + h * 128;
    unsigned kgo[2], vgo[2];
#pragma unroll
    for (int i = 0; i < 2; ++i) { const int kr = 4 * (2 * wid + i) + (lane >> 4), vr = 8 * (2 * wid + i) + (lane >> 3);
        kgo[i] = (unsigned)(kr * 1024 + (((lane & 15) ^ (kr & 15)) * 8)) * 2u;
        vgo[i] = (unsigned)(kr * 1024 + (((lane & 15) ^ (((kr & 3) << 2) | ((kr >> 2) & 3))) * 8)) * 2u; (void)vr; }
#define DMAT(kt, bf) do { const char* kb_ = (const char*)Kbh + (size_t)(unsigned)__builtin_amdgcn_readfirstlane((kt) * 131072); \
        const char* vb_ = (const char*)Vbh + (size_t)(unsigned)__builtin_amdgcn_readfirstlane((kt) * 131072); \
        _Pragma("unroll") for (int i_ = 0; i_ < 2; ++i_) { \
        __builtin_amdgcn_global_load_lds((const unsigned*)(kb_ + kgo[i_]), (LAS unsigned*)(lds + (bf) * KT_BYTES + (2 * wid + i_) * 1024), 16, 0, 0); \
        __builtin_amdgcn_global_load_lds((const unsigned*)(vb_ + vgo[i_]), (LAS unsigned*)(lds + LDS_VOFF + (bf) * VT_BYTES + (2 * wid + i_) * 1024), 16, 0, 0); } } while (0)
    const int krow = pi32(j32);
    const int kbase = krow * 256 + (((krow & 15) ^ hi) << 4);
    const int vbase = j32 * 128 + ((((j32 >> 1) & 7) ^ hi) << 4);
    const LAS unsigned char* kptr[2][4]; const LAS unsigned char* vptr[4][2];
#pragma unroll
    for (int c = 0; c < 2; ++c)
#pragma unroll
        for (int s_ = 0; s_ < 4; ++s_) kptr[c][s_] = lds + (kbase ^ ((c * 8 + s_ * 2) << 4));
    {
      const int q_ = (lane >> 2) & 3, p_ = lane & 3, g_ = (lane >> 4) & 1;
#pragma unroll
      for (int dt = 0; dt < 4; ++dt)
#pragma unroll
          for (int h4 = 0; h4 < 2; ++h4) { const int row_ = 8 * hi + 4 * h4 + q_, f_ = (q_ << 2) | ((2 * hi + h4) & 3), ch_ = dt * 4 + g_ * 2 + (p_ >> 1);
              vptr[dt][h4] = lds + LDS_VOFF + 256 * row_ + 16 * (ch_ ^ f_) + 8 * (p_ & 1); } }
#define WAIT_BAR(N) asm volatile("s_waitcnt vmcnt(" #N ") lgkmcnt(0)\n\ts_barrier" ::: "memory")
    asm volatile("s_waitcnt vmcnt(0)" ::: "memory");
    DMAT(NT - 1, 0); DMAT(NT - 2, 1);
#pragma unroll 1
    for (int it0 = 0; it0 < NT; it0 += NBUF) {
#pragma unroll
        for (int buf = 0; buf < NBUF; ++buf) {
            const int it = it0 + buf;
            if (it < NT) {
                const int kt = NT - 1 - it;
                if (it + 1 < NT) WAIT_BAR(4); else WAIT_BAR(0);
                if (it + 2 < NT) DMAT(kt - 2, (buf + 2) % NBUF);
#pragma unroll
                for (int st = 1; st >= 0; --st) {
                    const int sub = 2 * kt + st;
                    if (sub < nsub_w) {
                        const float cb = sl2 * (float)(sub * 32 - qpos);
                        attn_sub<true>(O, qlds, mrun, lrun, kptr, vptr, buf * KT_BYTES + st * 8192, buf * VT_BYTES + st * 8192, cinit, cb, j32, hi, sub == nsub_w - 1);
                    }
                }
            }
        }
    }
    asm volatile("s_waitcnt lgkmcnt(0)\n\ts_barrier" ::: "memory");
#undef WAIT_BAR
#undef DMAT
    const float inv0 = 1.f / hsum32(lrun[0]), k1 = -lam / hsum32(lrun[1]);
    float ss = 0.f;
#pragma unroll
    for (int dt = 0; dt < 4; ++dt)
#pragma unroll
        for (int r = 0; r < 16; ++r) { const float o = O[0][dt][r] * inv0 + O[1][dt][r] * k1; O[0][dt][r] = o; ss += o * o; }
    const float rs = rsqrtf(hsum32(ss) * (1.f / 128.f) + EPS) * (1.f - LAM_INIT);
    int hie = hi, qpe = qpos; asm volatile("" : "+v"(hie), "+v"(qpe));
    const size_t orow = (tokbase + qpe) * 1024 + h * 128;
#pragma unroll
    for (int dt = 0; dt < 4; ++dt)
#pragma unroll
        for (int rq = 0; rq < 4; ++rq) { const int dv = 32 * dt + 8 * rq + 4 * hie;
            const f32x4 gs = *(const f32x4*)(gsub + dv); const u32x2 zz = *(const u32x2*)(Zs + orow + dv);
            u32x2 w; w.x = pk2(O[0][dt][4 * rq] * rs * gs.x * bflo(zz.x), O[0][dt][4 * rq + 1] * rs * gs.y * bfhi(zz.x));
            w.y = pk2(O[0][dt][4 * rq + 2] * rs * gs.z * bflo(zz.y), O[0][dt][4 * rq + 3] * rs * gs.w * bfhi(zz.y));
            *(u32x2*)(og + orow + dv) = w; }
}

__device__ __forceinline__ void attn_phase(LAS unsigned char* lds, const bf16_t* Qb, const bf16_t* Kb, const bf16_t* VT, const bf16_t* Zs, bf16_t* og, const float* gsub, float lam) {
    for (int vb = blockIdx.x; vb < 256; vb += gridDim.x) {
        const int bh = vb & 127, half = vb >> 7;
#pragma unroll 1
        for (int ui = 0; ui < 4; ++ui) {
            const int qb = half == 0 ? (ui == 0 ? 7 : ui == 1 ? 0 : ui == 2 ? 5 : 2) : (ui == 0 ? 6 : ui == 1 ? 1 : ui == 2 ? 4 : 3);
            attn_unit(lds, bh >> 3, bh & 7, qb, Qb, Kb, VT, Zs, og, gsub, lam);
        }
    }
}

#ifndef REP_PH
#define REP_PH -1
#endif
#ifndef REP_N
#define REP_N 1
#endif
#define NREP(k) ((k) == REP_PH ? REP_N : 1)
#ifndef N_CG_SYNC
#define N_CG_SYNC 0
#endif
#ifndef MK_MULTI
#define MK_MULTI 0
#endif
__global__ void __launch_bounds__(NTHREADS, 2) yoco_fwd(Args a) {
    extern __shared__ __attribute__((aligned(16))) unsigned char lds_raw[];
    LAS unsigned char* lds = (LAS unsigned char*)lds_raw;
    cg::grid_group grid = cg::this_grid();
    const int tid = threadIdx.x, lane = tid & 63, wave = __builtin_amdgcn_readfirstlane(tid >> 6);
    const int lo = a.ph_lo, hi = a.ph_hi;
    const XcdBarrier xbar = xcd_barrier_init((unsigned*)(a.ws + WS_CTL), (volatile LAS unsigned*)lds);
    unsigned char* ws = a.ws;
    bf16_t* SA = (bf16_t*)(ws + WS_A); bf16_t* SB = (bf16_t*)(ws + WS_B); bf16_t* SC = (bf16_t*)(ws + WS_C); bf16_t* SF = (bf16_t*)(ws + WS_F); bf16_t* SG = (bf16_t*)(ws + WS_G); bf16_t* SH = (bf16_t*)(ws + WS_H);
#define IN(k) (lo <= (k) && (k) < hi)
#define SEAM(k) do { if (IN(k) && IN((k) + 1)) { if ((k) < N_CG_SYNC) grid.sync(); else xcd_barrier(xbar); } } while (0)
    if (lo > hi) grid.sync();
    if (IN(0)) { for (int rep = 0; rep < NREP(0); ++rep) p0_phase(a, lds, lane, wave); }
    SEAM(0);
    if (IN(1)) {
        pg8::Gemm g{SA, (const bf16_t*)(ws + WS_WT1), MTOK, 3072, 1024}; pg8::StaticOrder S; S.init(MTOK, 3072, gridDim.x, blockIdx.x); S.rep = NREP(1);
        pg8::EpiGlu E{SB, SC};
        pg8::gemm_phase<pg8::EpiGlu, pg8::StaticOrder, true, true>(lds, g, S, E);
    }
    SEAM(1);
    if (IN(2)) { for (int rep = 0; rep < NREP(2); ++rep) conv_phase(lds, SB, SC, SH, a.in[3], a.in[4], a.in[5], a.in[6]); }
    SEAM(2);
    if (IN(3)) {
        pg8::Gemm g{SH, (const bf16_t*)(ws + WS_WT2), MTOK, 1024, 1024}; pg8::StaticOrder S; S.init(MTOK, 1024, gridDim.x, blockIdx.x); S.rep = NREP(3);
        pg8::EpiPlain E{SB, 1024, 1.f};
        pg8::gemm_phase<pg8::EpiPlain, pg8::StaticOrder, true, true>(lds, g, S, E);
    }
    SEAM(3);
    if (IN(4)) { for (int rep = 0; rep < NREP(4); ++rep) resid_phase<true>(SA, (const float*)(ws + WS_RS0), SB, a.in[8], nullptr, (float*)(ws + WS_RS), SH, lane, wave); }
    SEAM(4);
    if (IN(5)) {
        {
            static_assert(WS_WT3V == WS_WT3 + (size_t)3072 * 1024 * 2 && WS_G - WS_F == WS_C - WS_B, "K|Q|Z|V weights contiguous, output slots equally spaced");
            pg8::Gemm g{SH, (const bf16_t*)(ws + WS_WT3), MTOK, 4096, 1024}; pg8::StaticOrder S; S.init(MTOK, 4096, gridDim.x, blockIdx.x); S.rep = NREP(5);
            pg8::EpiKQZ E{SB, (size_t)(WS_C - WS_B) / 2, 0.125f * LOG2E};   static_assert(WS_C - WS_B == WS_F - WS_C, "K|Q|Z slots equally spaced");
            pg8::gemm_phase<pg8::EpiKQZ, pg8::StaticOrder, true, true>(lds, g, S, E);
        }
    }
    SEAM(5);
    if (IN(6)) {
        const float* lp = a.in[13];
        const float sa = wave_sum(lp[lane] * lp[64 + lane]), sb = wave_sum(lp[128 + lane] * lp[192 + lane]);
        const float lam = expf(sa) - expf(sb) + LAM_INIT;
        for (int rep = 0; rep < NREP(6); ++rep) attn_phase(lds, SC, SB, SG, SF, SA, a.in[14], lam);
    }
    SEAM(6);
    if (IN(7)) {
        pg8::Gemm g{SA, (const bf16_t*)(ws + WS_WT4), MTOK, 1024, 1024}; pg8::StaticOrder S; S.init(MTOK, 1024, gridDim.x, blockIdx.x);
        pg8::EpiPlain E{SB, 1024, 1.f};
        pg8::gemm_phase<pg8::EpiPlain, pg8::StaticOrder, true, true>(lds, g, S, E);
    }
    SEAM(7);
    if (IN(8)) { resid_phase<false>(SH, (const float*)(ws + WS_RS), SB, a.in[16], a.out, nullptr, nullptr, lane, wave); }
#undef IN
#undef SEAM
}

extern "C" void kernel_launch(void* const* d_in, const int* in_sizes, int n_in, void* d_out, int out_size, void* d_ws, size_t ws_size, hipStream_t stream) {
    static int grid = 0;
    if (grid == 0) {
        if (n_in != 17 || in_sizes[0] != MTOK * DM || out_size != MTOK * DM || ws_size < WS_END) {
            fprintf(stderr, "kernel_launch: unexpected shapes (n_in %d in0 %d out %d ws %zu)\n", n_in, n_in > 0 ? in_sizes[0] : -1, out_size, ws_size); grid = -1; return; }
        int dev = 0, cus = 0, per_cu = 0;
        hipGetDevice(&dev);
        hipDeviceGetAttribute(&cus, hipDeviceAttributeMultiprocessorCount, dev);
        if (hipFuncSetAttribute((const void*)yoco_fwd, hipFuncAttributeMaxDynamicSharedMemorySize, LDS_BYTES) != hipSuccess) fprintf(stderr, "kernel_launch: hipFuncSetAttribute failed\n");
        if (hipOccupancyMaxActiveBlocksPerMultiprocessor(&per_cu, (const void*)yoco_fwd, NTHREADS, LDS_BYTES) != hipSuccess || per_cu < 1) {
            fprintf(stderr, "kernel_launch: occupancy query says %d blocks/CU\n", per_cu); per_cu = 1; }
        (void)hipGetLastError();
        grid = cus * per_cu; if (grid > 256) grid = 256;
        fprintf(stderr, "kernel_launch: grid %d (cus %d, per_cu %d)\n", grid, cus, per_cu);
    }
    if (grid < 0) return;
    if (hipMemsetAsync((char*)d_ws + WS_CTL, 0, CTL_BYTES, stream) != hipSuccess) fprintf(stderr, "kernel_launch: memset of the barrier words failed\n");
    Args a{};
    for (int i = 0; i < 17; ++i) a.in[i] = (const float*)d_in[i];
    a.out = (float*)d_out; a.ws = (unsigned char*)d_ws;
#if MK_MULTI
    for (int p = 0; p < 9; ++p) { a.ph_lo = p; a.ph_hi = p + 1; hipLaunchKernelGGL(yoco_fwd, dim3(grid), dim3(NTHREADS), LDS_BYTES, stream, a); }
#else
    a.ph_lo = 0; a.ph_hi = 9;
    void* args[] = {&a};
    hipError_t e = hipLaunchCooperativeKernel((const void*)yoco_fwd, dim3(grid), dim3(NTHREADS), args, LDS_BYTES, stream);
    if (e != hipSuccess) fprintf(stderr, "cooperative launch failed: %s (grid %d)\n", hipGetErrorString(e), grid);
#endif
}
```

```cpp
#include <hip/hip_runtime.h>
#include <hip/hip_cooperative_groups.h>
#include <cstdio>
#include <cstdint>
namespace cg = cooperative_groups;
namespace pg8 {
#define PG8_LAS __attribute__((address_space(3)))
typedef unsigned short bf16_t;
typedef short bf16x8 __attribute__((ext_vector_type(8)));
typedef float f32x4 __attribute__((ext_vector_type(4)));
typedef unsigned u32x4 __attribute__((ext_vector_type(4)));
constexpr int BM = 256, BK = 64, HALF = 128, HTB = HALF * BK * 2  , STAGE_BYTES = 8 * HTB, NXCD = 8, WGM = 4;

__host__ __device__ __forceinline__ int lds_byte(int r, int c) { const int st = (r >> 4) * 2 + (c >> 5), rr = r & 15, cc = c & 31, ob = rr * 64 + cc * 2; return st * 1024 + (ob ^ (((ob >> 9) & 1) << 5)); }
__host__ __device__ __forceinline__ void stage_rc(int b, int& R, int& C) { const int st = b / 1024, sb = b % 1024, swz = sb ^ (((sb >> 9) & 1) << 5); R = (st >> 1) * 16 + swz / 64; C = (st & 1) * 32 + (swz % 64) / 2; }
__host__ __device__ __forceinline__ int perm32(int rho) { const int n = rho >> 4, i = rho & 15; return 8 * (i >> 2) + 4 * n + (i & 3); }

struct Unit { int pm, pn; };
struct Gemm { const bf16_t* A; const bf16_t* Bt; int M, N, K; };

struct StaticOrder {
    int nM, nN, nwg, G, c, rep = 1;
    __host__ __device__ void init(int M, int N, int G_, int c_) { nM = M / BM; nN = N / BM; nwg = nM * nN; G = G_; c = c_; }
    __host__ __device__ bool next(int i, Unit& u) const {
        long L = (long)i * G + c; if (L >= (long)nwg * rep) return false;
        if (L >= nwg) L -= nwg;
        int wgid = (int)L; { const int q = nwg / NXCD, r = nwg % NXCD, xcd = wgid % NXCD, off = wgid / NXCD; wgid = (xcd < r ? xcd * (q + 1) : r * (q + 1) + (xcd - r) * q) + off; }
        const int nig = WGM * nN, gid = wgid / nig, fm = gid * WGM, gsz = (nM - fm) < WGM ? (nM - fm) : WGM;
        u.pm = fm + ((wgid % nig) % gsz); u.pn = (wgid % nig) / gsz; return true;
    }
    __device__ __forceinline__ void a_ready(const Unit&) const {}
    __device__ __forceinline__ void done(const Unit&) const {}
};

typedef float f32x2 __attribute__((ext_vector_type(2)));
typedef __bf16 bf16x2c __attribute__((ext_vector_type(2)));
__device__ __forceinline__ unsigned cvt_pk_bf16(float lo, float hi) { const f32x2 v = {lo, hi}; const bf16x2c b = __builtin_convertvector(v, bf16x2c); return __builtin_bit_cast(unsigned, b); }
template <class Epi, class Sched, bool ALIGN_EPI = false, bool SP2 = false>
__device__ __forceinline__ void gemm_phase(PG8_LAS unsigned char* lds, const Gemm g, const Sched& S, const Epi& E) {
    const int tid = threadIdx.x, wid = __builtin_amdgcn_readfirstlane(tid >> 6), lane = tid & 63, wr = wid >> 2, wc = wid & 3, fr = lane & 15, fq = lane >> 4;
    const int K = g.K, nt = K / BK;
    unsigned voffA[2], voffB[2];
#pragma unroll
    for (int i = 0; i < 2; ++i) { int R, C; stage_rc(tid * 16 + i * 8192, R, C); const int Rb = Epi::PERM ? ((R & ~31) + perm32(R & 31)) : R;
        voffA[i] = (unsigned)(R * K + C) * 2u; voffB[i] = (unsigned)(Rb * K + C) * 2u; }
    const size_t kstep = (size_t)(BK * 2);
    const size_t hstep = (size_t)HALF * K * 2;
    const size_t tstep = 2 * hstep;
    const unsigned ldsw = (unsigned)wid * 1024u;
    const int aoff = lds_byte(wr * 64 + fr, fq * 8), boff = lds_byte(wc * 32 + fr, fq * 8);
#define PG8_SA(b, h) (((b) * 2 + (h)) * HTB)
#define PG8_SB(b, h) ((4 + (b) * 2 + (h)) * HTB)
#define PG8_STAGE(bufoff, gbase, voff) do { _Pragma("unroll") for (int _i = 0; _i < 2; ++_i) \
        __builtin_amdgcn_global_load_lds((const unsigned*)((const char*)(gbase) + (voff)[_i]), (PG8_LAS unsigned*)(lds + (bufoff) + ldsw + _i * 8192), 16, 0, 0); } while (0)
#define PG8_LDA(dst, b, h) do { _Pragma("unroll") for (int m = 0; m < 4; ++m) _Pragma("unroll") for (int k = 0; k < 2; ++k) dst[m][k] = *(const PG8_LAS bf16x8*)(lds + PG8_SA(b, h) + aoff + m * 2048 + k * 1024); } while (0)
#define PG8_LDB(dst, b, h) do { _Pragma("unroll") for (int n = 0; n < 2; ++n) _Pragma("unroll") for (int k = 0; k < 2; ++k) dst[n][k] = *(const PG8_LAS bf16x8*)(lds + PG8_SB(b, h) + boff + n * 2048 + k * 1024); } while (0)
#define PG8_MMA(ai, bj, At, Bt) do { __builtin_amdgcn_s_setprio(1); _Pragma("unroll") for (int m = 0; m < 4; ++m) _Pragma("unroll") for (int n = 0; n < 2; ++n) _Pragma("unroll") for (int k = 0; k < 2; ++k) \
        acc[ai][bj][m][n] = __builtin_amdgcn_mfma_f32_16x16x32_bf16(Bt[n][k], At[m][k], acc[ai][bj][m][n], 0, 0, 0); __builtin_amdgcn_s_setprio(0); } while (0)
#define PG8_WAIT_V(n) asm volatile("s_waitcnt vmcnt(" #n ")" ::: "memory")
#define PG8_WAIT_L(n) asm volatile("s_waitcnt lgkmcnt(" #n ")" ::: "memory")
#define PG8_BAR __builtin_amdgcn_s_barrier()
#define PG8_SCHED __builtin_amdgcn_sched_barrier(0)
    Unit cur, nxt; int ui = 0;
    if (!S.next(0, cur)) return;
    f32x4 acc[2][2][4][2];
#pragma unroll
    for (int a = 0; a < 2; ++a)
#pragma unroll
        for (int b = 0; b < 2; ++b)
#pragma unroll
            for (int m = 0; m < 4; ++m)
#pragma unroll
                for (int n = 0; n < 2; ++n) acc[a][b][m][n] = (f32x4){0.f, 0.f, 0.f, 0.f};
    bf16x8 At[4][2], B0[2][2], B1[2][2];
    const char* cA = (const char*)g.A + (size_t)cur.pm * tstep; const char* cB = (const char*)g.Bt + (size_t)cur.pn * tstep;
    S.a_ready(cur);
    if constexpr (SP2) {
        PG8_STAGE(PG8_SB(0, 0), cB, voffB); PG8_STAGE(PG8_SB(0, 1), cB + hstep, voffB); PG8_STAGE(PG8_SA(0, 0), cA, voffA); PG8_STAGE(PG8_SA(0, 1), cA + hstep, voffA);
        if (wr == 1) PG8_BAR;
        PG8_WAIT_V(2); PG8_BAR;
        PG8_STAGE(PG8_SB(1, 0), cB + kstep, voffB); PG8_STAGE(PG8_SA(1, 0), cA + kstep, voffA); PG8_STAGE(PG8_SB(1, 1), cB + hstep + kstep, voffB);
        PG8_WAIT_V(6); PG8_BAR;
    } else {
        PG8_STAGE(PG8_SB(0, 0), cB, voffB); PG8_STAGE(PG8_SA(0, 0), cA, voffA); PG8_STAGE(PG8_SB(0, 1), cB + hstep, voffB); PG8_STAGE(PG8_SA(0, 1), cA + hstep, voffA);
        if (wr == 1) PG8_BAR;
        PG8_WAIT_V(4); PG8_BAR;
        PG8_STAGE(PG8_SB(1, 0), cB + kstep, voffB); PG8_STAGE(PG8_SA(1, 0), cA + kstep, voffA); PG8_STAGE(PG8_SB(1, 1), cB + hstep + kstep, voffB);
        PG8_WAIT_V(6); PG8_BAR;
    }
    for (;;) {
        const bool has_next = S.next(ui + 1, nxt);
        const char* nA = has_next ? (const char*)g.A + (size_t)nxt.pm * tstep : cA; const char* nB = has_next ? (const char*)g.Bt + (size_t)nxt.pn * tstep : cB;
        for (int t = 0; t < nt; t += 2) {
            const bool last = (t == nt - 2);
            const char* a1 = cA + (size_t)(t + 1) * kstep;
            const char* a2 = last ? nA : cA + (size_t)(t + 2) * kstep; const char* b2 = last ? nB : cB + (size_t)(t + 2) * kstep;
            const char* a3 = a2 + kstep; const char* b3 = b2 + kstep;
            if (last && has_next) S.a_ready(nxt);
            if constexpr (SP2) {
            PG8_LDB(B0, 0, 0); PG8_LDB(B1, 0, 1); PG8_SCHED; PG8_LDA(At, 0, 0); PG8_STAGE(PG8_SA(1, 1), a1 + hstep, voffA);
            PG8_WAIT_V(8); PG8_WAIT_L(0); PG8_BAR; PG8_MMA(0, 0, At, B0); PG8_MMA(0, 1, At, B1); PG8_BAR; PG8_SCHED;
            PG8_LDA(At, 0, 1); PG8_STAGE(PG8_SB(0, 0), b2, voffB); PG8_STAGE(PG8_SB(0, 1), b2 + hstep, voffB); PG8_STAGE(PG8_SA(0, 0), a2, voffA);
            PG8_WAIT_V(8); PG8_WAIT_L(0); PG8_BAR; PG8_MMA(1, 0, At, B0); PG8_MMA(1, 1, At, B1); PG8_BAR; PG8_SCHED;
            PG8_LDB(B0, 1, 0); PG8_LDB(B1, 1, 1); PG8_SCHED; PG8_LDA(At, 1, 0); PG8_STAGE(PG8_SA(0, 1), a2 + hstep, voffA);
            PG8_WAIT_V(8); PG8_WAIT_L(0); PG8_BAR; PG8_MMA(0, 0, At, B0); PG8_MMA(0, 1, At, B1); PG8_BAR; PG8_SCHED;
            PG8_LDA(At, 1, 1); PG8_STAGE(PG8_SB(1, 0), b3, voffB); PG8_STAGE(PG8_SB(1, 1), b3 + hstep, voffB); PG8_STAGE(PG8_SA(1, 0), a3, voffA);
            PG8_WAIT_V(8); PG8_WAIT_L(0); PG8_BAR; PG8_MMA(1, 0, At, B0); PG8_MMA(1, 1, At, B1); PG8_BAR; PG8_SCHED;
            } else {
            PG8_LDB(B0, 0, 0); PG8_SCHED; PG8_LDA(At, 0, 0); PG8_STAGE(PG8_SA(1, 1), a1 + hstep, voffA);
            PG8_WAIT_L(8); PG8_BAR; PG8_WAIT_L(0); PG8_MMA(0, 0, At, B0); PG8_BAR; PG8_SCHED;
            PG8_LDB(B1, 0, 1); PG8_STAGE(PG8_SB(0, 0), b2, voffB);
            PG8_BAR; PG8_WAIT_L(0); PG8_MMA(0, 1, At, B1); PG8_BAR;
            PG8_LDA(At, 0, 1); PG8_STAGE(PG8_SA(0, 0), a2, voffA);
            PG8_BAR; PG8_WAIT_L(0); PG8_MMA(1, 0, At, B0); PG8_BAR; PG8_SCHED;
            PG8_STAGE(PG8_SB(0, 1), b2 + hstep, voffB);
            PG8_WAIT_V(6); PG8_BAR; PG8_MMA(1, 1, At, B1); PG8_BAR;
            PG8_LDB(B0, 1, 0); PG8_SCHED; PG8_LDA(At, 1, 0); PG8_STAGE(PG8_SA(0, 1), a2 + hstep, voffA);
            PG8_WAIT_L(8); PG8_BAR; PG8_WAIT_L(0); PG8_MMA(0, 0, At, B0); PG8_BAR; PG8_SCHED;
            PG8_LDB(B1, 1, 1); PG8_STAGE(PG8_SB(1, 0), b3, voffB);
            PG8_BAR; PG8_WAIT_L(0); PG8_MMA(0, 1, At, B1); PG8_BAR;
            PG8_LDA(At, 1, 1); PG8_STAGE(PG8_SA(1, 0), a3, voffA);
            PG8_BAR; PG8_WAIT_L(0); PG8_MMA(1, 0, At, B0); PG8_BAR; PG8_SCHED;
            PG8_STAGE(PG8_SB(1, 1), b3 + hstep, voffB);
            PG8_WAIT_V(6); PG8_BAR; PG8_MMA(1, 1, At, B1); PG8_BAR;
            }
        }
        if constexpr (ALIGN_EPI) { if (wr == 0) PG8_BAR; }
        if constexpr (!Epi::AFTER_DRAIN) { E(acc, cur, wr, wc, fr, fq); S.done(cur); }
        if (!has_next) break;
#pragma unroll
        for (int a = 0; a < 2; ++a)
#pragma unroll
            for (int b = 0; b < 2; ++b)
#pragma unroll
                for (int m = 0; m < 4; ++m)
#pragma unroll
                    for (int n = 0; n < 2; ++n) acc[a][b][m][n] = (f32x4){0.f, 0.f, 0.f, 0.f};
        cur = nxt; cA = nA; cB = nB; ++ui;
        if constexpr (ALIGN_EPI) { if (wr == 1) PG8_BAR; }
    }
    PG8_WAIT_V(0);
    if constexpr (!ALIGN_EPI) { if (wr == 0) PG8_BAR; }
    PG8_BAR;
    if constexpr (Epi::AFTER_DRAIN) { E.fused(acc, cur, wr, wc, fr, fq, lds, wid, lane); S.done(cur); }
#undef PG8_SA
#undef PG8_SB
#undef PG8_STAGE
#undef PG8_LDA
#undef PG8_LDB
#undef PG8_MMA
#undef PG8_WAIT_V
#undef PG8_WAIT_L
#undef PG8_BAR
#undef PG8_SCHED
}
}

namespace pg8 {
__device__ __forceinline__ float sigm(float v) { return __builtin_amdgcn_rcpf(1.f + __builtin_amdgcn_exp2f(-1.4426950408889634f * v)); }
struct EpiPlain {
    static constexpr bool PERM = true, AFTER_DRAIN = false;
    bf16_t* O; int ldc; float scale;
    __device__ __forceinline__ void operator()(const f32x4 (&acc)[2][2][4][2], const Unit& u, int wr, int wc, int fr, int fq) const {
        const int row0 = u.pm * BM + wr * 64 + fr, col0 = u.pn * BM + wc * 32 + 8 * fq;
#pragma unroll
        for (int ai = 0; ai < 2; ++ai)
#pragma unroll
            for (int m = 0; m < 4; ++m) { bf16_t* rowp = O + (size_t)(row0 + ai * HALF + m * 16) * ldc + col0;
#pragma unroll
                for (int bj = 0; bj < 2; ++bj) { const f32x4 v0 = acc[ai][bj][m][0] * scale, v1 = acc[ai][bj][m][1] * scale;
                    u32x4 w; w.x = cvt_pk_bf16(v0[0], v0[1]); w.y = cvt_pk_bf16(v0[2], v0[3]); w.z = cvt_pk_bf16(v1[0], v1[1]); w.w = cvt_pk_bf16(v1[2], v1[3]);
                    *(u32x4*)(rowp + bj * HALF) = w; } }
    }
};
struct EpiGlu {
    static constexpr bool PERM = true, AFTER_DRAIN = false;
    bf16_t* G; bf16_t* SZ;
    __device__ __forceinline__ void operator()(const f32x4 (&acc)[2][2][4][2], const Unit& u, int wr, int wc, int fr, int fq) const {
        const int row0 = u.pm * BM + wr * 64 + fr;
        if (u.pn < 8) {
            const int col0 = u.pn * HALF + wc * 32 + 8 * fq;
#pragma unroll
            for (int ai = 0; ai < 2; ++ai)
#pragma unroll
                for (int m = 0; m < 4; ++m) { bf16_t* rowp = G + (size_t)(row0 + ai * HALF + m * 16) * 1024 + col0;
                    f32x4 v0, v1;
#pragma unroll
                    for (int j = 0; j < 4; ++j) { v0[j] = acc[ai][0][m][0][j] * sigm(acc[ai][1][m][0][j]); v1[j] = acc[ai][0][m][1][j] * sigm(acc[ai][1][m][1][j]); }
                    u32x4 w; w.x = cvt_pk_bf16(v0[0], v0[1]); w.y = cvt_pk_bf16(v0[2], v0[3]); w.z = cvt_pk_bf16(v1[0], v1[1]); w.w = cvt_pk_bf16(v1[2], v1[3]);
                    *(u32x4*)rowp = w; }
        } else {
            const int col0 = (u.pn - 8) * BM + wc * 32 + 8 * fq;
#pragma unroll
            for (int ai = 0; ai < 2; ++ai)
#pragma unroll
                for (int m = 0; m < 4; ++m) { bf16_t* rowp = SZ + (size_t)(row0 + ai * HALF + m * 16) * 1024 + col0;
#pragma unroll
                    for (int bj = 0; bj < 2; ++bj) { f32x4 v0 = acc[ai][bj][m][0], v1 = acc[ai][bj][m][1];
#pragma unroll
                        for (int j = 0; j < 4; ++j) { v0[j] = v0[j] * sigm(v0[j]); v1[j] = v1[j] * sigm(v1[j]); }
                        u32x4 w; w.x = cvt_pk_bf16(v0[0], v0[1]); w.y = cvt_pk_bf16(v0[2], v0[3]); w.z = cvt_pk_bf16(v1[0], v1[1]); w.w = cvt_pk_bf16(v1[2], v1[3]);
                        *(u32x4*)(rowp + bj * HALF) = w; } }
        }
    }
};
struct EpiKQZ {
    static constexpr bool PERM = true, AFTER_DRAIN = false;
    bf16_t* Kb; size_t seg_stride; float qscale;
    __device__ __forceinline__ void operator()(const f32x4 (&acc)[2][2][4][2], const Unit& u, int wr, int wc, int fr, int fq) const {
        const int row0 = u.pm * BM + wr * 64 + fr; const int seg = u.pn >> 2;
        bf16_t* base = Kb + (size_t)seg * seg_stride;
        const float sc = seg == 1 ? qscale : 1.f;
        const int col0 = (u.pn & 3) * BM + wc * 32 + 8 * fq;
#pragma unroll
        for (int ai = 0; ai < 2; ++ai)
#pragma unroll
            for (int m = 0; m < 4; ++m) { bf16_t* rowp = base + (size_t)(row0 + ai * HALF + m * 16) * 1024 + col0;
#pragma unroll
                for (int bj = 0; bj < 2; ++bj) { f32x4 v0 = acc[ai][bj][m][0] * sc, v1 = acc[ai][bj][m][1] * sc;
                    if (seg == 2) {
#pragma unroll
                        for (int j = 0; j < 4; ++j) { v0[j] = v0[j] * sigm(v0[j]); v1[j] = v1[j] * sigm(v1[j]); } }
                    u32x4 w; w.x = cvt_pk_bf16(v0[0], v0[1]); w.y = cvt_pk_bf16(v0[2], v0[3]); w.z = cvt_pk_bf16(v1[0], v1[1]); w.w = cvt_pk_bf16(v1[2], v1[3]);
                    *(u32x4*)(rowp + bj * HALF) = w; } }
    }
};
}

#define LAS __attribute__((address_space(3)))
typedef pg8::bf16_t bf16_t;
typedef pg8::bf16x8 bf16x8;
typedef pg8::f32x4 f32x4;
typedef pg8::u32x4 u32x4;
typedef float f32x16 __attribute__((ext_vector_type(16)));
typedef float f32x2v __attribute__((ext_vector_type(2)));
typedef unsigned u32x2 __attribute__((ext_vector_type(2)));

constexpr int BATCH = 16, SEQ = 2048, DM = 1024, MTOK = BATCH * SEQ;
constexpr int NH = 8, CK = 31;
constexpr float EPS = 1e-6f;
constexpr float LOG2E = 1.4426950408889634f;
constexpr float LAM_INIT = 0.4707130183435842f;
constexpr int NTHREADS = 512, NWAVES = 8;
constexpr int NRF0 = 8;
constexpr int NRF = 4;
constexpr int LDS_BYTES = 163840;
constexpr size_t MiB = 1u << 20;
constexpr size_t WS_WT1 = 0, WS_WT2 = 6 * MiB, WS_WT3 = 8 * MiB, WS_WT3V = 14 * MiB, WS_WT4 = 16 * MiB;
constexpr size_t WS_RS0 = 22 * MiB;
constexpr size_t WS_RS = 21 * MiB;
constexpr size_t WS_CTL = 20 * MiB, CTL_BYTES = 16384;
constexpr size_t WS_A = 32 * MiB, WS_B = 96 * MiB, WS_C = 160 * MiB, WS_F = 224 * MiB, WS_G = 288 * MiB, WS_H = 352 * MiB, WS_END = 416 * MiB;

struct Args { const float* in[17]; float* out; unsigned char* ws; int ph_lo, ph_hi; };

__device__ __forceinline__ float wave_sum(float v) {
#pragma unroll
    for (int o = 1; o < 64; o <<= 1) v += __shfl_xor(v, o);
    return v;
}
typedef __bf16 bf16x2_t __attribute__((ext_vector_type(2)));
__device__ __forceinline__ unsigned pk2(float lo, float hi) { const f32x2v v = {lo, hi}; const bf16x2_t b = __builtin_convertvector(v, bf16x2_t); return __builtin_bit_cast(unsigned, b); }
__device__ __forceinline__ float bflo(unsigned u) { return __builtin_bit_cast(float, u << 16); }
__device__ __forceinline__ float bfhi(unsigned u) { return __builtin_bit_cast(float, u & 0xffff0000u); }
#define LDS_WAIT() asm volatile("s_waitcnt lgkmcnt(0)" ::: "memory")

__device__ __forceinline__ void transpose_item(const float* W, int ldw, int col0, const float* gain, bf16_t* WT, int dst_row0, LAS float* scr, int kb, int lane) {
    const int k0 = 64 * kb;
    float wv[32];
#pragma unroll
    for (int i = 0; i < 32; ++i) { const int kk = 2 * i + (lane >> 5); wv[i] = W[(size_t)(k0 + kk) * ldw + col0 + (lane & 31)]; }
#pragma unroll
    for (int i = 0; i < 32; ++i) { const int kk = 2 * i + (lane >> 5); const float gg = gain ? gain[k0 + kk] : 1.f; scr[kk * 33 + (lane & 31)] = wv[i] * gg; }
    LDS_WAIT();
    const int c = lane & 7;
#pragma unroll
    for (int j = 0; j < 4; ++j) { const int n = (lane >> 3) + 8 * j; const LAS float* s = scr + (8 * c) * 33 + n;
        u32x4 o; o.x = pk2(s[0 * 33], s[1 * 33]); o.y = pk2(s[2 * 33], s[3 * 33]); o.z = pk2(s[4 * 33], s[5 * 33]); o.w = pk2(s[6 * 33], s[7 * 33]);
        *(u32x4*)(WT + (size_t)(dst_row0 + n) * 1024 + k0 + 8 * c) = o; }
    LDS_WAIT();
}

__device__ __forceinline__ void rms_row_to_bf16(const float* xrow, bf16_t* orow, int lane) {
    const f32x4* xr = (const f32x4*)xrow + lane;
    f32x4 v[4]; float s = 0.f;
#pragma unroll
    for (int j = 0; j < 4; ++j) { v[j] = xr[64 * j]; s += (v[j].x * v[j].x + v[j].y * v[j].y) + (v[j].z * v[j].z + v[j].w * v[j].w); }
    const float r = rsqrtf(wave_sum(s) * (1.f / DM) + EPS);
    u32x2* o8 = (u32x2*)orow + lane;
#pragma unroll
    for (int j = 0; j < 4; ++j) { u32x2 w; w.x = pk2(v[j].x * r, v[j].y * r); w.y = pk2(v[j].z * r, v[j].w * r); o8[64 * j] = w; }
}

__device__ __forceinline__ void p0_phase(const Args& a, LAS unsigned char* lds, int lane, int wave) {
    LAS float* scr = (LAS float*)(lds + wave * 16384);
    constexpr int NWT = 2, NWR = NWAVES - NWT;
    unsigned char* ws = a.ws;
    const bool is_tw = wave >= NWR;
    const int gw = is_tw ? blockIdx.x * NWT + (wave - NWR) : blockIdx.x * NWR + wave, NGW = is_tw ? gridDim.x * NWT : gridDim.x * NWR;
    if (is_tw)
    for (int it = gw; it < 9 * 512; it += NGW) {
        const int piece = it >> 9, r = it & 511, kb = r >> 5, cb = (r & 31) * 32;
        switch (piece) {
        case 0: transpose_item(a.in[2], 3072, cb, a.in[1], (bf16_t*)(ws + WS_WT1), (cb >> 7) * 256 + (cb & 127), scr, kb, lane); break;
        case 1: transpose_item(a.in[2], 3072, 1024 + cb, a.in[1], (bf16_t*)(ws + WS_WT1), (cb >> 7) * 256 + 128 + (cb & 127), scr, kb, lane); break;
        case 2: transpose_item(a.in[2], 3072, 2048 + cb, a.in[1], (bf16_t*)(ws + WS_WT1), 2048 + cb, scr, kb, lane); break;
        case 3: transpose_item(a.in[7], 1024, cb, nullptr, (bf16_t*)(ws + WS_WT2), cb, scr, kb, lane); break;
        case 4: transpose_item(a.in[10], 2048, cb, a.in[9], (bf16_t*)(ws + WS_WT3), cb, scr, kb, lane); break;
        case 5: transpose_item(a.in[10], 2048, 1024 + cb, a.in[9], (bf16_t*)(ws + WS_WT3V), cb, scr, kb, lane); break;
        case 6: transpose_item(a.in[12], 2048, cb, a.in[11], (bf16_t*)(ws + WS_WT3), 1024 + cb, scr, kb, lane); break;
        case 7: transpose_item(a.in[12], 2048, 1024 + cb, a.in[11], (bf16_t*)(ws + WS_WT3), 2048 + cb, scr, kb, lane); break;
        default: transpose_item(a.in[15], 1024, cb, nullptr, (bf16_t*)(ws + WS_WT4), cb, scr, kb, lane); break;
        }
    }
    bf16_t* xn0 = (bf16_t*)(ws + WS_A);
    if (!is_tw)
    for (int m0 = gw; m0 < MTOK; m0 += NRF0 * NGW) {
        f32x4 v[NRF0][4];
#pragma unroll
        for (int rr = 0; rr < NRF0; ++rr) { const int m = m0 + rr * NGW; if (m < MTOK) { const f32x4* xr = (const f32x4*)(a.in[0] + (size_t)m * DM) + lane;
#pragma unroll
            for (int j = 0; j < 4; ++j) v[rr][j] = __builtin_nontemporal_load(xr + 64 * j); } }
#pragma unroll
        for (int rr = 0; rr < NRF0; ++rr) { const int m = m0 + rr * NGW; if (m < MTOK) { float sq = 0.f;
#pragma unroll
            for (int j = 0; j < 4; ++j) sq += (v[rr][j].x * v[rr][j].x + v[rr][j].y * v[rr][j].y) + (v[rr][j].z * v[rr][j].z + v[rr][j].w * v[rr][j].w);
            const float r = rsqrtf(wave_sum(sq) * (1.f / DM) + EPS);
            if (lane == 0) ((float*)(ws + WS_RS0))[m] = 1.f / r;
            u32x2* o8 = (u32x2*)(xn0 + (size_t)m * DM) + lane;
#pragma unroll
            for (int j = 0; j < 4; ++j) { u32x2 w; w.x = pk2(v[rr][j].x * r, v[rr][j].y * r); w.y = pk2(v[rr][j].z * r, v[rr][j].w * r); o8[64 * j] = w; } } }
    }
}

#define RS_STEP(N, MASK) { const bool up_ = (lane & (MASK)) != 0; _Pragma("unroll") for (int i_ = 0; i_ < (N) / 2; ++i_) { \
        const float keep_ = up_ ? rv[i_ + (N) / 2] : rv[i_], send_ = up_ ? rv[i_] : rv[i_ + (N) / 2]; rv[i_] = keep_ + __shfl_xor(send_, (MASK)); } }
__device__ __forceinline__ void conv_phase(LAS unsigned char* lds, const bf16_t* g, const bf16_t* sz, bf16_t* cgo,
                                           const float* wdw, const float* bdw, const float* lng, const float* lnb) {
    const int tid = threadIdx.x, lane = tid & 63, wave = tid >> 6;
    LAS float* red = (LAS float*)(lds + 131072);
    LAS float* stat = red + 128;
    f32x2v w[CK];
#pragma unroll
    for (int k = 0; k < CK; ++k) w[k] = *(const f32x2v*)(wdw + k * 1024 + 2 * tid);
    const f32x2v bb = *(const f32x2v*)(bdw + 2 * tid), lg = *(const f32x2v*)(lng + 2 * tid), lb = *(const f32x2v*)(lnb + 2 * tid);
    for (int chunk = blockIdx.x; chunk < MTOK / 128; chunk += gridDim.x) {
        const int c0 = chunk * 128, s0 = c0 & (SEQ - 1);
        __syncthreads();
        for (int id = tid; id < 62 * 128; id += NTHREADS) { const int row = id >> 7, ch = id & 127;
            u32x4 v = {0u, 0u, 0u, 0u};
            if (s0 - 30 + row >= 0) v = *(const u32x4*)(g + (size_t)(c0 - 30 + row) * 1024 + ch * 8);
            *(LAS u32x4*)(lds + row * 2048 + ch * 16) = v; }
        __syncthreads();
#pragma unroll 1
        for (int tile = 0; tile < 4; ++tile) {
            u32x4 pf[8];
            if (tile < 3) {
#pragma unroll
                for (int i = 0; i < 8; ++i) { const int id = tid + NTHREADS * i; pf[i] = __builtin_nontemporal_load((const u32x4*)(g + (size_t)(c0 + 32 + 32 * tile + (id >> 7)) * 1024 + (id & 127) * 8)); } }
#pragma unroll 1
            for (int gq = 0; gq < 4; ++gq) {
                const int rbase = (32 * tile + 8 * gq) & 63;
                f32x2v v[38];
#pragma unroll
                for (int i = 0; i < 38; ++i) { const int slot = (rbase + i) & 63; const unsigned u = *(const LAS unsigned*)(lds + slot * 2048 + tid * 4); v[i] = (f32x2v){bflo(u), bfhi(u)}; }
                unsigned zz[8];
#pragma unroll
                for (int tt = 0; tt < 8; ++tt) zz[tt] = *(const unsigned*)(sz + (size_t)(c0 + 32 * tile + gq * 8 + tt) * 1024 + 2 * tid);
                f32x2v cv[8];
#pragma unroll
                for (int tt = 0; tt < 8; ++tt) { f32x2v acc = bb;
#pragma unroll
                    for (int k = 0; k < CK; ++k) acc = __builtin_elementwise_fma(w[k], v[tt + k], acc);
                    cv[tt] = acc; }
                float rv[16];
#pragma unroll
                for (int tt = 0; tt < 8; ++tt) { rv[2 * tt] = cv[tt].x + cv[tt].y; rv[2 * tt + 1] = cv[tt].x * cv[tt].x + cv[tt].y * cv[tt].y; }
                RS_STEP(16, 32) RS_STEP(8, 16) RS_STEP(4, 8) RS_STEP(2, 4)
                rv[0] += __shfl_xor(rv[0], 2); rv[0] += __shfl_xor(rv[0], 1);
                if ((lane & 3) == 0) red[wave * 16 + (lane >> 2)] = rv[0];
                __syncthreads();
                if (tid < 8) { float s = 0.f, q = 0.f;
#pragma unroll
                    for (int ww = 0; ww < 8; ++ww) { s += red[ww * 16 + 2 * tid]; q += red[ww * 16 + 2 * tid + 1]; }
                    const float mu = s * (1.f / 1024.f), var = fmaxf(q * (1.f / 1024.f) - mu * mu, 0.f);
                    stat[2 * tid] = mu; stat[2 * tid + 1] = rsqrtf(var + EPS); }
                __syncthreads();
#pragma unroll
                for (int tt = 0; tt < 8; ++tt) { const float mu = stat[2 * tt], rs = stat[2 * tt + 1];
                    float n0 = (cv[tt].x - mu) * rs * lg.x + lb.x, n1 = (cv[tt].y - mu) * rs * lg.y + lb.y;
                    n0 = n0 * pg8::sigm(n0) * bflo(zz[tt]); n1 = n1 * pg8::sigm(n1) * bfhi(zz[tt]);
                    *(unsigned*)(cgo + (size_t)(c0 + 32 * tile + gq * 8 + tt) * 1024 + 2 * tid) = pk2(n0, n1); }
            }
            if (tile < 3) {
#pragma unroll
                for (int i = 0; i < 8; ++i) { const int id = tid + NTHREADS * i; const int slot = (62 + 32 * tile + (id >> 7)) & 63;
                    *(LAS u32x4*)(lds + slot * 2048 + (id & 127) * 16) = pf[i]; }
                __syncthreads();
            }
        }
    }
}

template <bool FIRST>
__device__ __forceinline__ void resid_phase(const bf16_t* xinb, const float* rs_in, const bf16_t* y, const float* gpost, float* xout, float* rs_out, bf16_t* xn, int lane, int wave) {
    const int gw = blockIdx.x * NWAVES + wave, NGW = gridDim.x * NWAVES;
    f32x4 gp[4];
#pragma unroll
    for (int j = 0; j < 4; ++j) gp[j] = ((const f32x4*)gpost)[lane + 64 * j];
    for (int m0 = gw; m0 < MTOK; m0 += NRF * NGW) {
        f32x4 xv[NRF][4], yv[NRF][4]; float s[NRF];
#pragma unroll
        for (int rr = 0; rr < NRF; ++rr) s[rr] = 0.f;
#pragma unroll
        for (int rr = 0; rr < NRF; ++rr) { const int m = m0 + rr * NGW; if (m < MTOK) {
            const u32x2* yr = (const u32x2*)(y + (size_t)m * DM) + lane;
            { const u32x2* xr = (const u32x2*)(xinb + (size_t)m * DM) + lane; const float rsc = rs_in[m];
#pragma unroll
                for (int j = 0; j < 4; ++j) { const u32x2 u = __builtin_nontemporal_load(xr + 64 * j); xv[rr][j] = (f32x4){bflo(u.x), bfhi(u.x), bflo(u.y), bfhi(u.y)} * rsc; } }
#pragma unroll
            for (int j = 0; j < 4; ++j) { const u32x2 u = __builtin_nontemporal_load(yr + 64 * j); yv[rr][j] = (f32x4){bflo(u.x), bfhi(u.x), bflo(u.y), bfhi(u.y)}; } } }
#pragma unroll
        for (int rr = 0; rr < NRF; ++rr) { const int m = m0 + rr * NGW; if (m < MTOK) {
#pragma unroll
            for (int j = 0; j < 4; ++j) s[rr] += (yv[rr][j].x * yv[rr][j].x + yv[rr][j].y * yv[rr][j].y) + (yv[rr][j].z * yv[rr][j].z + yv[rr][j].w * yv[rr][j].w);
            const float r = rsqrtf(wave_sum(s[rr]) * (1.f / DM) + EPS);
            float s1 = 0.f;
#pragma unroll
            for (int j = 0; j < 4; ++j) { xv[rr][j] = xv[rr][j] + yv[rr][j] * r * gp[j];
                s1 += (xv[rr][j].x * xv[rr][j].x + xv[rr][j].y * xv[rr][j].y) + (xv[rr][j].z * xv[rr][j].z + xv[rr][j].w * xv[rr][j].w); }
            if (FIRST) {
                const float r1 = rsqrtf(wave_sum(s1) * (1.f / DM) + EPS);
                u32x2* o8 = (u32x2*)(xn + (size_t)m * DM) + lane;
                if (lane == 0) rs_out[m] = 1.f / r1;
#pragma unroll
                for (int j = 0; j < 4; ++j) { u32x2 w; w.x = pk2(xv[rr][j].x * r1, xv[rr][j].y * r1); w.y = pk2(xv[rr][j].z * r1, xv[rr][j].w * r1); o8[64 * j] = w; }
            } else {
                f32x4* xo = (f32x4*)(xout + (size_t)m * DM) + lane;
#pragma unroll
                for (int j = 0; j < 4; ++j) __builtin_nontemporal_store(xv[rr][j], xo + 64 * j);
            } } }
    }
}
#define XB_TMO      128
#define XB_XCNT(j)  (256  + 64 * (j))
#define XB_XSUB(j)  (1280 + 64 * (j))
#define XB_XGEN(j)  (2304 + 64 * (j))
#define XB_TOP      3328
#define XB_TOPGEN   3392
#define XCD_BAR_WORDS 3456
#define XB_SPIN_CAP (1u << 18)

__device__ __forceinline__ unsigned xb_ld(unsigned* p)              { return __hip_atomic_load(p, __ATOMIC_RELAXED, __HIP_MEMORY_SCOPE_AGENT); }
__device__ __forceinline__ unsigned xb_add(unsigned* p, unsigned v) { return __hip_atomic_fetch_add(p, v, __ATOMIC_RELAXED, __HIP_MEMORY_SCOPE_AGENT); }
__device__ __forceinline__ unsigned xb_xcc_id() { return (unsigned)__builtin_amdgcn_s_getreg((3 << 11) | 20) & 0xFu; }
#define XB_SPIN(cond, bar) do { unsigned _sp = 0; while (cond) { __builtin_amdgcn_s_sleep(1); \
    if ((++_sp & 255u) == 0u) { if (xb_ld(&(bar)[XB_TMO])) break; if (_sp > XB_SPIN_CAP) { atomicAdd(&(bar)[XB_TMO], 1u); break; } } } } while (0)

struct XcdBarrier {
    unsigned* bar; unsigned x, nloc, nx;
};

__device__ __forceinline__ void xcd_barrier_complete(unsigned* bar, unsigned x, unsigned& nloc, unsigned& nx) {
    const unsigned G = gridDim.x * gridDim.y * gridDim.z;
    unsigned sum, cnt, mine, sp = 0u;
    for (;;) {
        sum = 0u; cnt = 0u; mine = 0u;
#pragma unroll
        for (unsigned j = 0; j < 16; ++j) { const unsigned c = xb_ld(&bar[XB_XCNT(j)]); sum += c; cnt += (c > 0u) ? 1u : 0u; mine = (j == x) ? c : mine; }
        if (sum == G) break;
        __builtin_amdgcn_s_sleep(1);
        if ((++sp & 255u) == 0u) { if (xb_ld(&bar[XB_TMO])) break; if (sp > XB_SPIN_CAP) { atomicAdd(&bar[XB_TMO], 1u); break; } }
    }
    nloc = mine > 0u ? mine : 1u; nx = cnt > 0u ? cnt : 1u;
}

__device__ __forceinline__ void xcd_barrier(const XcdBarrier& b) {
    asm volatile("s_waitcnt vmcnt(0)" ::: "memory");
    __syncthreads();
    if (threadIdx.x == 0) {
        unsigned* bar = b.bar;
        __builtin_amdgcn_s_waitcnt(0);
        const unsigned nloc = b.nloc, nx = b.nx;
        const unsigned old = xb_add(&bar[XB_XSUB(b.x)], 1u);
        const unsigned gen = old / nloc;
        if (old + 1u == (gen + 1u) * nloc) {
            __builtin_amdgcn_fence(__ATOMIC_RELEASE, "agent");
            asm volatile("s_waitcnt vmcnt(0)" ::: "memory");
            const unsigned og = xb_add(&bar[XB_TOP], 1u);
            const unsigned tg = og / nx;
            if (og + 1u == (tg + 1u) * nx) xb_add(&bar[XB_TOPGEN], 1u);
            else XB_SPIN(xb_ld(&bar[XB_TOPGEN]) == tg, bar);
            __builtin_amdgcn_fence(__ATOMIC_ACQUIRE, "agent");
            xb_add(&bar[XB_XGEN(b.x)], 1u);
            asm volatile("s_waitcnt vmcnt(0)" ::: "memory");
        } else {
            XB_SPIN(xb_ld(&bar[XB_XGEN(b.x)]) == gen, bar);
            __builtin_amdgcn_fence(__ATOMIC_ACQUIRE, "agent");
            asm volatile("s_waitcnt vmcnt(0)" ::: "memory");
        }
    }
    __syncthreads();
}
__device__ __forceinline__ XcdBarrier xcd_barrier_init(unsigned* bar, volatile LAS unsigned* tmp) {
    XcdBarrier b; b.bar = bar; b.x = xb_xcc_id();
    if (threadIdx.x == 0) { (void)xb_add(&bar[XB_XCNT(b.x)], 1u); unsigned nloc, nx; xcd_barrier_complete(bar, b.x, nloc, nx); tmp[0] = nloc; tmp[1] = nx; }
    __syncthreads();
    b.nloc = (unsigned)__builtin_amdgcn_readfirstlane((int)tmp[0]); b.nx = (unsigned)__builtin_amdgcn_readfirstlane((int)tmp[1]);
    __syncthreads();
    return b;
}


constexpr int KT_BYTES = 64 * 256, VT_BYTES = 128 * 128, NBUF = 3, LDS_VOFF = NBUF * KT_BYTES, LDS_QOFF = NBUF * (KT_BYTES + VT_BYTES);
typedef short v4i16_t __attribute__((ext_vector_type(4)));
__device__ __forceinline__ v4i16_t vtr16(const LAS unsigned char* p) { return __builtin_amdgcn_ds_read_tr16_b64_v4i16((LAS v4i16_t*)p); }
__device__ __forceinline__ int pi32(int i) { return (i & ~12) | ((i & 4) << 1) | ((i & 8) >> 1); }
__device__ __forceinline__ float hmax32(float v) { auto rr = __builtin_amdgcn_permlane32_swap(__float_as_uint(v), __float_as_uint(v), false, false); return fmaxf(__uint_as_float(rr[0]), __uint_as_float(rr[1])); }
__device__ __forceinline__ float hsum32(float v) { auto rr = __builtin_amdgcn_permlane32_swap(__float_as_uint(v), __float_as_uint(v), false, false); return __uint_as_float(rr[0]) + __uint_as_float(rr[1]); }

template <bool DIAG>
__device__ __forceinline__ void attn_sub(f32x16 (&O)[2][4], const LAS unsigned char* qlds, float (&mrun)[2], float (&lrun)[2],
                                         const LAS unsigned char* const (&kptr)[2][4], const LAS unsigned char* const (&vptr)[4][2], int koff, int voff, const f32x16& cinit, float cb, int j32, int hi, bool isdiag) {
    f32x16 x0, x1;
#pragma unroll
    for (int sh = 0; sh < 2; ++sh) {
        bf16x8 kf[2][2], qv[2][2];
#pragma unroll
        for (int c = 0; c < 2; ++c)
#pragma unroll
            for (int s2 = 0; s2 < 2; ++s2) { kf[c][s2] = *(const LAS bf16x8*)(kptr[c][sh * 2 + s2] + koff); qv[c][s2] = *(const LAS bf16x8*)(qlds + (c * 4 + sh * 2 + s2) * 1024); }
        if (sh == 0) {
            x0 = __builtin_amdgcn_mfma_f32_32x32x16_bf16(kf[0][0], qv[0][0], cinit, 0, 0, 0); x1 = __builtin_amdgcn_mfma_f32_32x32x16_bf16(kf[1][0], qv[1][0], cinit, 0, 0, 0);
            x0 = __builtin_amdgcn_mfma_f32_32x32x16_bf16(kf[0][1], qv[0][1], x0, 0, 0, 0); x1 = __builtin_amdgcn_mfma_f32_32x32x16_bf16(kf[1][1], qv[1][1], x1, 0, 0, 0);
        } else {
#pragma unroll
            for (int s2 = 0; s2 < 2; ++s2) { x0 = __builtin_amdgcn_mfma_f32_32x32x16_bf16(kf[0][s2], qv[0][s2], x0, 0, 0, 0); x1 = __builtin_amdgcn_mfma_f32_32x32x16_bf16(kf[1][s2], qv[1][s2], x1, 0, 0, 0); }
        }
        __builtin_amdgcn_sched_barrier(0);
    }
    if (isdiag) {
#pragma unroll
        for (int r = 0; r < 16; ++r) { const int kk = 16 * (r >> 3) + 8 * hi + (r & 7); if (kk > j32) { x0[r] = -INFINITY; x1[r] = -INFINITY; } } }
    float mx0 = fmaxf(x0[0], x0[1]), mx1 = fmaxf(x1[0], x1[1]);
#pragma unroll
    for (int r = 2; r < 16; r += 2) { mx0 = fmaxf(fmaxf(mx0, x0[r]), x0[r + 1]); mx1 = fmaxf(fmaxf(mx1, x1[r]), x1[r + 1]); }
    const float mc0 = hmax32(mx0) + cb, mc1 = hmax32(mx1) + cb;
    if (__any((mc0 > mrun[0] + 8.f) || (mc1 > mrun[1] + 8.f))) {
        const float mn0 = fmaxf(mrun[0], mc0), al0 = __builtin_amdgcn_exp2f(mrun[0] - mn0), mn1 = fmaxf(mrun[1], mc1), al1 = __builtin_amdgcn_exp2f(mrun[1] - mn1);
        lrun[0] *= al0; lrun[1] *= al1; mrun[0] = mn0; mrun[1] = mn1;
#pragma unroll
        for (int dt = 0; dt < 4; ++dt)
#pragma unroll
            for (int r = 0; r < 16; ++r) { O[0][dt][r] *= al0; O[1][dt][r] *= al1; }
    }
    const float off0 = cb - mrun[0], off1 = cb - mrun[1];
    float ls0 = 0.f, ls1 = 0.f;
#pragma unroll
    for (int r = 0; r < 16; ++r) { x0[r] = __builtin_amdgcn_exp2f(x0[r] + off0); ls0 += x0[r]; x1[r] = __builtin_amdgcn_exp2f(x1[r] + off1); ls1 += x1[r]; }
    lrun[0] += ls0; lrun[1] += ls1;
    bf16x8 p0[2], p1[2];
#pragma unroll
    for (int t = 0; t < 2; ++t) {
        p0[t] = __builtin_bit_cast(bf16x8, (u32x4){pk2(x0[8 * t], x0[8 * t + 1]), pk2(x0[8 * t + 2], x0[8 * t + 3]), pk2(x0[8 * t + 4], x0[8 * t + 5]), pk2(x0[8 * t + 6], x0[8 * t + 7])});
        p1[t] = __builtin_bit_cast(bf16x8, (u32x4){pk2(x1[8 * t], x1[8 * t + 1]), pk2(x1[8 * t + 2], x1[8 * t + 3]), pk2(x1[8 * t + 4], x1[8 * t + 5]), pk2(x1[8 * t + 6], x1[8 * t + 7])}); }
#pragma unroll
    for (int dt = 0; dt < 4; ++dt) {
        bf16x8 vf[2];
#pragma unroll
        for (int t = 0; t < 2; ++t) { const v4i16_t lo_ = vtr16(vptr[dt][0] + voff + t * 4096), hi_ = vtr16(vptr[dt][1] + voff + t * 4096);
            vf[t] = (bf16x8){lo_[0], lo_[1], lo_[2], lo_[3], hi_[0], hi_[1], hi_[2], hi_[3]}; }
#pragma unroll
        for (int t = 0; t < 2; ++t) {
            O[0][dt] = __builtin_amdgcn_mfma_f32_32x32x16_bf16(vf[t], p0[t], O[0][dt], 0, 0, 0);
            O[1][dt] = __builtin_amdgcn_mfma_f32_32x32x16_bf16(vf[t], p1[t], O[1][dt], 0, 0, 0); }
    }
}

__device__ __forceinline__ void attn_unit(LAS unsigned char* lds, int b, int h, int qb, const bf16_t* Qb, const bf16_t* Kb, const bf16_t* VT, const bf16_t* Zs, bf16_t* og,
                                          const float* gsub, float lam) {
    const int tid = threadIdx.x, lane = tid & 63, j32 = lane & 31, hi = lane >> 5; const int wid = __builtin_amdgcn_readfirstlane(tid >> 6);
    const float sl2 = exp2f(-(float)(h + 1)) * LOG2E;
    const size_t tokbase = (size_t)b * SEQ;
    const int q0w = qb * 256 + wid * 32, qpos = q0w + j32;
    LAS unsigned char* qlds = lds + LDS_QOFF + wid * 8192 + lane * 16;
    { const bf16_t* qp = Qb + (tokbase + qpos) * 1024 + h * 128 + hi * 8;
#pragma unroll
      for (int c = 0; c < 2; ++c)
#pragma unroll
          for (int s = 0; s < 4; ++s) *(LAS bf16x8*)(qlds + (c * 4 + s) * 1024) = *(const bf16x8*)(qp + c * 64 + s * 16); }
    f32x16 O[2][4];
#pragma unroll
    for (int c = 0; c < 2; ++c)
#pragma unroll
        for (int dt = 0; dt < 4; ++dt)
#pragma unroll
            for (int r = 0; r < 16; ++r) O[c][dt][r] = 0.f;
    float mrun[2] = {-1e30f, -1e30f}, lrun[2] = {0.f, 0.f};
    f32x16 cinit;
    { int hio = hi; asm volatile("" : "+v"(hio));
#pragma unroll
      for (int r = 0; r < 16; ++r) cinit[r] = sl2 * (float)(16 * (r >> 3) + 8 * hio + (r & 7)); }
    const int nsub_w = qb * 8 + wid + 1, NT = 4 * qb + 4;
    const bf16_t* Kbh = Kb + tokbase * 1024 + h * 128;
    const bf16_t* Vbh = VT + tokbase * 1024 + h * 128;
    unsigned kgo[2], vgo[2];
#pragma unroll
    for (int i = 0; i < 2; ++i) { const int kr = 4 * (2 * wid + i) + (lane >> 4), vr = 8 * (2 * wid + i) + (lane >> 3);
        kgo[i] = (unsigned)(kr * 1024 + (((lane & 15) ^ (kr & 15)) * 8)) * 2u;
        vgo[i] = (unsigned)(kr * 1024 + (((lane & 15) ^ (((kr & 3) << 2) | ((kr >> 2) & 3))) * 8)) * 2u; (void)vr; }
#define DMAT(kt, bf) do { const char* kb_ = (const char*)Kbh + (size_t)(unsigned)__builtin_amdgcn_readfirstlane((kt) * 131072); \
        const char* vb_ = (const char*)Vbh + (size_t)(unsigned)__builtin_amdgcn_readfirstlane((kt) * 131072); \
        _Pragma("unroll") for (int i_ = 0; i_ < 2; ++i_) { \
        __builtin_amdgcn_global_load_lds((const unsigned*)(kb_ + kgo[i_]), (LAS unsigned*)(lds + (bf) * KT_BYTES + (2 * wid + i_) * 1024), 16, 0, 0); \
        __builtin_amdgcn_global_load_lds((const unsigned*)(vb_ + vgo[i_]), (LAS unsigned*)(lds + LDS_VOFF + (bf) * VT_BYTES + (2 * wid + i_) * 1024), 16, 0, 0); } } while (0)
    const int krow = pi32(j32);
    const int kbase = krow * 256 + (((krow & 15) ^ hi) << 4);
    const int vbase = j32 * 128 + ((((j32 >> 1) & 7) ^ hi) << 4);
    const LAS unsigned char* kptr[2][4]; const LAS unsigned char* vptr[4][2];
#pragma unroll
    for (int c = 0; c < 2; ++c)
#pragma unroll
        for (int s_ = 0; s_ < 4; ++s_) kptr[c][s_] = lds + (kbase ^ ((c * 8 + s_ * 2) << 4));
    {
      const int q_ = (lane >> 2) & 3, p_ = lane & 3, g_ = (lane >> 4) & 1;
#pragma unroll
      for (int dt = 0; dt < 4; ++dt)
#pragma unroll
          for (int h4 = 0; h4 < 2; ++h4) { const int row_ = 8 * hi + 4 * h4 + q_, f_ = (q_ << 2) | ((2 * hi + h4) & 3), ch_ = dt * 4 + g_ * 2 + (p_ >> 1);
              vptr[dt][h4] = lds + LDS_VOFF + 256 * row_ + 16 * (ch_ ^ f_) + 8 * (p_ & 1); } }
#define WAIT_BAR(N) asm volatile("s_waitcnt vmcnt(" #N ") lgkmcnt(0)\n\ts_barrier" ::: "memory")
    asm volatile("s_waitcnt vmcnt(0)" ::: "memory");
    DMAT(NT - 1, 0); DMAT(NT - 2, 1);
#pragma unroll 1
    for (int it0 = 0; it0 < NT; it0 += NBUF) {
#pragma unroll
        for (int buf = 0; buf < NBUF; ++buf) {
            const int it = it0 + buf;
            if (it < NT) {
                const int kt = NT - 1 - it;
                if (it + 1 < NT) WAIT_BAR(4); else WAIT_BAR(0);
                if (it + 2 < NT) DMAT(kt - 2, (buf + 2) % NBUF);
#pragma unroll
                for (int st = 1; st >= 0; --st) {
                    const int sub = 2 * kt + st;
                    if (sub < nsub_w) {
                        const float cb = sl2 * (float)(sub * 32 - qpos);
                        attn_sub<true>(O, qlds, mrun, lrun, kptr, vptr, buf * KT_BYTES + st * 8192, buf * VT_BYTES + st * 8192, cinit, cb, j32, hi, sub == nsub_w - 1);
                    }
                }
            }
        }
    }
    asm volatile("s_waitcnt lgkmcnt(0)\n\ts_barrier" ::: "memory");
#undef WAIT_BAR
#undef DMAT
    const float inv0 = 1.f / hsum32(lrun[0]), k1 = -lam / hsum32(lrun[1]);
    float ss = 0.f;
#pragma unroll
    for (int dt = 0; dt < 4; ++dt)
#pragma unroll
        for (int r = 0; r < 16; ++r) { const float o = O[0][dt][r] * inv0 + O[1][dt][r] * k1; O[0][dt][r] = o; ss += o * o; }
    const float rs = rsqrtf(hsum32(ss) * (1.f / 128.f) + EPS) * (1.f - LAM_INIT);
    int hie = hi, qpe = qpos; asm volatile("" : "+v"(hie), "+v"(qpe));
    const size_t orow = (tokbase + qpe) * 1024 + h * 128;
#pragma unroll
    for (int dt = 0; dt < 4; ++dt)
#pragma unroll
        for (int rq = 0; rq < 4; ++rq) { const int dv = 32 * dt + 8 * rq + 4 * hie;
            const f32x4 gs = *(const f32x4*)(gsub + dv); const u32x2 zz = *(const u32x2*)(Zs + orow + dv);
            u32x2 w; w.x = pk2(O[0][dt][4 * rq] * rs * gs.x * bflo(zz.x), O[0][dt][4 * rq + 1] * rs * gs.y * bfhi(zz.x));
            w.y = pk2(O[0][dt][4 * rq + 2] * rs * gs.z * bflo(zz.y), O[0][dt][4 * rq + 3] * rs * gs.w * bfhi(zz.y));
            *(u32x2*)(og + orow + dv) = w; }
}

__device__ __forceinline__ void attn_phase(LAS unsigned char* lds, const bf16_t* Qb, const bf16_t* Kb, const bf16_t* VT, const bf16_t* Zs, bf16_t* og, const float* gsub, float lam) {
    for (int vb = blockIdx.x; vb < 256; vb += gridDim.x) {
        const int bh = vb & 127, half = vb >> 7;
#pragma unroll 1
        for (int ui = 0; ui < 4; ++ui) {
            const int qb = half == 0 ? (ui == 0 ? 7 : ui == 1 ? 1 : ui == 2 ? 4 : 2) : (ui == 0 ? 0 : ui == 1 ? 6 : ui == 2 ? 5 : 3);
            attn_unit(lds, bh >> 3, bh & 7, qb, Qb, Kb, VT, Zs, og, gsub, lam);
        }
    }
}

#ifndef REP_PH
#define REP_PH -1
#endif
#ifndef REP_N
#define REP_N 1
#endif
#define NREP(k) ((k) == REP_PH ? REP_N : 1)
#ifndef N_CG_SYNC
#define N_CG_SYNC 0
#endif
#ifndef MK_MULTI
#define MK_MULTI 0
#endif
__global__ void __launch_bounds__(NTHREADS, 2) yoco_fwd(Args a) {
    extern __shared__ __attribute__((aligned(16))) unsigned char lds_raw[];
    LAS unsigned char* lds = (LAS unsigned char*)lds_raw;
    cg::grid_group grid = cg::this_grid();
    const int tid = threadIdx.x, lane = tid & 63, wave = __builtin_amdgcn_readfirstlane(tid >> 6);
    const int lo = a.ph_lo, hi = a.ph_hi;
    const XcdBarrier xbar = xcd_barrier_init((unsigned*)(a.ws + WS_CTL), (volatile LAS unsigned*)lds);
    unsigned char* ws = a.ws;
    bf16_t* SA = (bf16_t*)(ws + WS_A); bf16_t* SB = (bf16_t*)(ws + WS_B); bf16_t* SC = (bf16_t*)(ws + WS_C); bf16_t* SF = (bf16_t*)(ws + WS_F); bf16_t* SG = (bf16_t*)(ws + WS_G); bf16_t* SH = (bf16_t*)(ws + WS_H);
#define IN(k) (lo <= (k) && (k) < hi)
#define SEAM(k) do { if (IN(k) && IN((k) + 1)) { if ((k) < N_CG_SYNC) grid.sync(); else xcd_barrier(xbar); } } while (0)
    if (lo > hi) grid.sync();
    if (IN(0)) { for (int rep = 0; rep < NREP(0); ++rep) p0_phase(a, lds, lane, wave); }
    SEAM(0);
    if (IN(1)) {
        pg8::Gemm g{SA, (const bf16_t*)(ws + WS_WT1), MTOK, 3072, 1024}; pg8::StaticOrder S; S.init(MTOK, 3072, gridDim.x, blockIdx.x); S.rep = NREP(1);
        pg8::EpiGlu E{SB, SC};
        pg8::gemm_phase<pg8::EpiGlu, pg8::StaticOrder, true, true>(lds, g, S, E);
    }
    SEAM(1);
    if (IN(2)) { for (int rep = 0; rep < NREP(2); ++rep) conv_phase(lds, SB, SC, SH, a.in[3], a.in[4], a.in[5], a.in[6]); }
    SEAM(2);
    if (IN(3)) {
        pg8::Gemm g{SH, (const bf16_t*)(ws + WS_WT2), MTOK, 1024, 1024}; pg8::StaticOrder S; S.init(MTOK, 1024, gridDim.x, blockIdx.x); S.rep = NREP(3);
        pg8::EpiPlain E{SB, 1024, 1.f};
        pg8::gemm_phase<pg8::EpiPlain, pg8::StaticOrder, true, true>(lds, g, S, E);
    }
    SEAM(3);
    if (IN(4)) { for (int rep = 0; rep < NREP(4); ++rep) resid_phase<true>(SA, (const float*)(ws + WS_RS0), SB, a.in[8], nullptr, (float*)(ws + WS_RS), SH, lane, wave); }
    SEAM(4);
    if (IN(5)) {
        {
            static_assert(WS_WT3V == WS_WT3 + (size_t)3072 * 1024 * 2 && WS_G - WS_F == WS_C - WS_B, "K|Q|Z|V weights contiguous, output slots equally spaced");
            pg8::Gemm g{SH, (const bf16_t*)(ws + WS_WT3), MTOK, 4096, 1024}; pg8::StaticOrder S; S.init(MTOK, 4096, gridDim.x, blockIdx.x); S.rep = NREP(5);
            pg8::EpiKQZ E{SB, (size_t)(WS_C - WS_B) / 2, 0.125f * LOG2E};   static_assert(WS_C - WS_B == WS_F - WS_C, "K|Q|Z slots equally spaced");
            pg8::gemm_phase<pg8::EpiKQZ, pg8::StaticOrder, true, true>(lds, g, S, E);
        }
    }
    SEAM(5);
    if (IN(6)) {
        const float* lp = a.in[13];
        const float sa = wave_sum(lp[lane] * lp[64 + lane]), sb = wave_sum(lp[128 + lane] * lp[192 + lane]);
        const float lam = expf(sa) - expf(sb) + LAM_INIT;
        for (int rep = 0; rep < NREP(6); ++rep) attn_phase(lds, SC, SB, SG, SF, SA, a.in[14], lam);
    }
    SEAM(6);
    if (IN(7)) {
        pg8::Gemm g{SA, (const bf16_t*)(ws + WS_WT4), MTOK, 1024, 1024}; pg8::StaticOrder S; S.init(MTOK, 1024, gridDim.x, blockIdx.x);
        pg8::EpiPlain E{SB, 1024, 1.f};
        pg8::gemm_phase<pg8::EpiPlain, pg8::StaticOrder, true, true>(lds, g, S, E);
    }
    SEAM(7);
    if (IN(8)) { resid_phase<false>(SH, (const float*)(ws + WS_RS), SB, a.in[16], a.out, nullptr, nullptr, lane, wave); }
#undef IN
#undef SEAM
}

extern "C" void kernel_launch(void* const* d_in, const int* in_sizes, int n_in, void* d_out, int out_size, void* d_ws, size_t ws_size, hipStream_t stream) {
    static int grid = 0;
    if (grid == 0) {
        if (n_in != 17 || in_sizes[0] != MTOK * DM || out_size != MTOK * DM || ws_size < WS_END) {
            fprintf(stderr, "kernel_launch: unexpected shapes (n_in %d in0 %d out %d ws %zu)\n", n_in, n_in > 0 ? in_sizes[0] : -1, out_size, ws_size); grid = -1; return; }
        int dev = 0, cus = 0, per_cu = 0;
        hipGetDevice(&dev);
        hipDeviceGetAttribute(&cus, hipDeviceAttributeMultiprocessorCount, dev);
        if (hipFuncSetAttribute((const void*)yoco_fwd, hipFuncAttributeMaxDynamicSharedMemorySize, LDS_BYTES) != hipSuccess) fprintf(stderr, "kernel_launch: hipFuncSetAttribute failed\n");
        if (hipOccupancyMaxActiveBlocksPerMultiprocessor(&per_cu, (const void*)yoco_fwd, NTHREADS, LDS_BYTES) != hipSuccess || per_cu < 1) {
            fprintf(stderr, "kernel_launch: occupancy query says %d blocks/CU\n", per_cu); per_cu = 1; }
        (void)hipGetLastError();
        grid = cus * per_cu; if (grid > 256) grid = 256;
        fprintf(stderr, "kernel_launch: grid %d (cus %d, per_cu %d)\n", grid, cus, per_cu);
    }
    if (grid < 0) return;
    if (hipMemsetAsync((char*)d_ws + WS_CTL, 0, CTL_BYTES, stream) != hipSuccess) fprintf(stderr, "kernel_launch: memset of the barrier words failed\n");
    Args a{};
    for (int i = 0; i < 17; ++i) a.in[i] = (const float*)d_in[i];
    a.out = (float*)d_out; a.ws = (unsigned char*)d_ws;
#if MK_MULTI
    for (int p = 0; p < 9; ++p) { a.ph_lo = p; a.ph_hi = p + 1; hipLaunchKernelGGL(yoco_fwd, dim3(grid), dim3(NTHREADS), LDS_BYTES, stream, a); }
#else
    a.ph_lo = 0; a.ph_hi = 9;
    void* args[] = {&a};
    hipError_t e = hipLaunchCooperativeKernel((const void*)yoco_fwd, dim3(grid), dim3(NTHREADS), args, LDS_BYTES, stream);
    if (e != hipSuccess) fprintf(stderr, "cooperative launch failed: %s (grid %d)\n", hipGetErrorString(e), grid);
#endif
}
```
